# Optimizing an MI355X kernel written in HIP

```python
import math
import jax, jax.numpy as jnp
from jax import lax
import numpy as np

D_MODEL = 1024
BATCH = 2
SEQ = 8192
DEPTH = 4

GRID_W = 64
NA_HEADS = 8
NA_HEAD_DIM = 64
NA_WIDTH = NA_HEADS * NA_HEAD_DIM
NA_KR_MAX = 8
NA_KW = 16
HY_WIDTH = 512
HY_SHORT = 3
HY_POS_BANDS = 16
HY_POS_DIM = 1 + 2 * HY_POS_BANDS
HY_FFN_HIDDEN = 64
HY_DECAY_TARGET = 1e-2
HY_FAST_PCT = 0.3
HY_SLOW_PCT = 1.5
HY_FILTER_SCALE = 0.03
N_BRANCHES = 2
IN_WIDTH = 3 * NA_WIDTH + 3 * HY_WIDTH + N_BRANCHES * D_MODEL
PEER_HEADS = 8
PEER_NKEYS = 128
PEER_N = PEER_NKEYS * PEER_NKEYS
PEER_DKEY = 256
PEER_TOPK = 16
PEER_CHUNK = 128
EPS = 1e-6

kernel_name = "hybrid_na_hyena_peer_encoder"


def rmsnorm(x, g):
    xf = x.astype(jnp.float32)
    y = xf * lax.rsqrt(jnp.mean(xf * xf, axis=-1, keepdims=True) + EPS)
    return (y * g.astype(jnp.float32)).astype(x.dtype)


def neighbourhood_attention(q, k, v, rpb):
    B, S, H, Dh = q.shape
    rows = S // GRID_W
    kr = min(NA_KR_MAX, rows)

    def to_grid(t):
        return t.reshape(B, rows, GRID_W, H, Dh).transpose(0, 3, 1, 2, 4)

    qg, kg, vg = to_grid(q), to_grid(k), to_grid(v)
    r = jnp.arange(rows)
    r0 = jnp.clip(r - kr // 2, 0, rows - kr)
    row_idx = r0[:, None] + jnp.arange(kr)[None, :]
    c = jnp.arange(GRID_W)
    c0 = jnp.clip(c - NA_KW // 2, 0, GRID_W - NA_KW)
    col_in = (c[None, :] >= c0[:, None]) & (c[None, :] < c0[:, None] + NA_KW)

    k_rows = kg[:, :, row_idx]
    v_rows = vg[:, :, row_idx]
    s = jnp.einsum('bhrqd,bhrjkd->bhrqjk', qg, k_rows).astype(jnp.float32) * (Dh ** -0.5)

    dr_idx = row_idx - r[:, None] + (NA_KR_MAX - 1)
    dc_idx = jnp.clip(c[None, :] - c[:, None] + (NA_KW - 1), 0, 2 * NA_KW - 2)
    bias = rpb.astype(jnp.float32)[:, dr_idx[:, None, :, None], dc_idx[None, :, None, :]]
    s = s + bias[None]
    s = jnp.where(col_in[:, None, :], s, -jnp.inf)
    p = jax.nn.softmax(s.reshape(B, H, rows, GRID_W, kr * GRID_W), axis=-1)
    p = p.reshape(B, H, rows, GRID_W, kr, GRID_W).astype(v.dtype)
    o = jnp.einsum('bhrqjk,bhrjkd->bhrqd', p, v_rows)
    return o.transpose(0, 2, 3, 1, 4).reshape(B, S, H * Dh)


def short_conv(u, w, b):
    up = jnp.pad(u, ((0, 0), (1, 1), (0, 0)))
    return up[:, :-2] * w[0] + up[:, 1:-1] * w[1] + up[:, 2:] * w[2] + b


def hyena_pos_features(L):
    t = jnp.linspace(0.0, 1.0, L, dtype=jnp.float32)[:, None]
    w = 2.0 * math.pi * jnp.arange(L, dtype=jnp.float32)[:, None] / L
    f = jnp.linspace(1e-4, HY_POS_BANDS - 1, HY_POS_BANDS, dtype=jnp.float32)[None, :]
    return jnp.concatenate([t, jnp.cos(f * w), -jnp.sin(f * w)], axis=-1), t


def hyena_filters(z, t, w1, b1, freq, w2, b2, w3):
    f32 = jnp.float32
    fr = freq.astype(f32)
    h = jnp.sin(fr * (z @ w1.astype(f32) + b1.astype(f32)))
    h = jnp.sin(fr * (h @ w2.astype(f32) + b2.astype(f32)))
    h = h @ w3.astype(f32)
    max_decay = math.log(HY_DECAY_TARGET) / HY_FAST_PCT
    min_decay = math.log(HY_DECAY_TARGET) / HY_SLOW_PCT
    deltas = jnp.linspace(min_decay, max_decay, HY_WIDTH, dtype=f32)
    decay = jnp.exp(-t * jnp.abs(deltas)[None, :])
    h = h.reshape(-1, 2, HY_WIDTH) * decay[:, None, :]
    return h[:, 0], h[:, 1]


def fft_conv(u, h):
    L = u.shape[1]
    n = 2 * L
    U = jnp.fft.rfft(u, n=n, axis=1)
    Hf = jnp.fft.rfft(h, n=n, axis=0)
    return jnp.fft.irfft(U * Hf[None], n=n, axis=1)[:, :L]


def hyena_mixer(u, h_fwd, h_bwd, skip_bias):
    x0, x1, vv = jnp.split(u.astype(jnp.float32), 3, axis=-1)
    z = vv * x1
    y = (fft_conv(z, h_fwd)
         + jnp.flip(fft_conv(jnp.flip(z, axis=1), h_bwd), axis=1)
         + z * skip_bias.astype(jnp.float32))
    return (y * x0).astype(u.dtype)


def peer(h, wq, subkeys, u_tab, v_tab):
    B, S, D = h.shape
    T = B * S
    half = PEER_DKEY // 2

    def chunk(xc):
        C = xc.shape[0]
        q = (xc @ wq).reshape(C, PEER_HEADS, 2, half)
        s = jnp.einsum('thpd,hpkd->thpk', q, subkeys).astype(jnp.float32)
        sv, si = lax.top_k(s, PEER_TOPK)
        cand = (sv[:, :, 0, :, None] + sv[:, :, 1, None, :]).reshape(C, PEER_HEADS, PEER_TOPK * PEER_TOPK)
        cid = (si[:, :, 0, :, None] * PEER_NKEYS + si[:, :, 1, None, :]).reshape(C, PEER_HEADS, PEER_TOPK * PEER_TOPK)
        fs, fi = lax.top_k(cand, PEER_TOPK)
        eid = jnp.take_along_axis(cid, fi, axis=-1)
        g = jax.nn.softmax(fs, axis=-1)
        u = u_tab[eid]
        a = jax.nn.gelu(jnp.einsum('tc,thkc->thk', xc, u).astype(jnp.float32))
        vg = v_tab[eid]
        return jnp.einsum('thk,thkc->tc', (g * a).astype(xc.dtype), vg)

    out = lax.map(chunk, h.reshape(T // PEER_CHUNK, PEER_CHUNK, D))
    return out.reshape(B, S, D)


def setup_inputs(seed: int = 0) -> dict:
    key = jax.random.key(seed)
    ks = iter(jax.random.split(key, 32))

    def nrm(shape, scale):
        return jax.random.normal(next(ks), shape, jnp.float32) * scale

    return {
        "x": nrm((BATCH, SEQ, D_MODEL), 1.0),
        "norm1_g": 1.0 + nrm((DEPTH, D_MODEL), 0.02),
        "w_in": nrm((DEPTH, D_MODEL, IN_WIDTH), D_MODEL ** -0.5),
        "gate_b": nrm((DEPTH, N_BRANCHES, D_MODEL), 0.02),
        "na_q_g": 1.0 + nrm((DEPTH, NA_HEAD_DIM), 0.02),
        "na_k_g": 1.0 + nrm((DEPTH, NA_HEAD_DIM), 0.02),
        "na_rpb": nrm((DEPTH, NA_HEADS, 2 * NA_KR_MAX - 1, 2 * NA_KW - 1), 0.02),
        "hy_conv_w": nrm((DEPTH, HY_SHORT, 3 * HY_WIDTH), HY_SHORT ** -0.5),
        "hy_conv_b": nrm((DEPTH, 3 * HY_WIDTH), 0.02),
        "hy_w1": nrm((DEPTH, HY_POS_DIM, HY_FFN_HIDDEN), HY_POS_DIM ** -0.5),
        "hy_b1": nrm((DEPTH, HY_FFN_HIDDEN), 0.02),
        "hy_freq": 1.0 + nrm((DEPTH, HY_FFN_HIDDEN), 0.02),
        "hy_w2": nrm((DEPTH, HY_FFN_HIDDEN, HY_FFN_HIDDEN), HY_FFN_HIDDEN ** -0.5),
        "hy_b2": nrm((DEPTH, HY_FFN_HIDDEN), 0.02),
        "hy_w3": nrm((DEPTH, HY_FFN_HIDDEN, 2 * HY_WIDTH), HY_FILTER_SCALE * HY_FFN_HIDDEN ** -0.5),
        "hy_bias": nrm((DEPTH, HY_WIDTH), 1.0),
        "w_up_na": nrm((DEPTH, NA_WIDTH, D_MODEL), NA_WIDTH ** -0.5),
        "w_up_hy": nrm((DEPTH, HY_WIDTH, D_MODEL), HY_WIDTH ** -0.5),
        "w_out": nrm((DEPTH, D_MODEL, D_MODEL), D_MODEL ** -0.5),
        "norm2_g": 1.0 + nrm((DEPTH, D_MODEL), 0.02),
        "peer_wq": nrm((DEPTH, D_MODEL, PEER_HEADS * PEER_DKEY), D_MODEL ** -0.5),
        "peer_subkeys": nrm((DEPTH, PEER_HEADS, 2, PEER_NKEYS, PEER_DKEY // 2), (PEER_DKEY // 2) ** -0.5),
        "peer_u": nrm((DEPTH, PEER_N, D_MODEL), D_MODEL ** -0.5),
        "peer_v": nrm((DEPTH, PEER_N, D_MODEL), D_MODEL ** -0.5),
    }


def reference(x, norm1_g, w_in, gate_b, na_q_g, na_k_g, na_rpb, hy_conv_w, hy_conv_b,
              hy_w1, hy_b1, hy_freq, hy_w2, hy_b2, hy_w3, hy_bias, w_up_na, w_up_hy,
              w_out, norm2_g, peer_wq, peer_subkeys, peer_u, peer_v):
    B, S, D = x.shape
    pos_z, pos_t = hyena_pos_features(S)
    splits = [NA_WIDTH, 2 * NA_WIDTH, 3 * NA_WIDTH, 3 * NA_WIDTH + 3 * HY_WIDTH]
    for l in range(DEPTH):
        hn = rmsnorm(x, norm1_g[l])
        proj = hn @ w_in[l]
        q, k, v, hy_in, gates = jnp.split(proj, splits, axis=-1)
        q = rmsnorm(q.reshape(B, S, NA_HEADS, NA_HEAD_DIM), na_q_g[l])
        k = rmsnorm(k.reshape(B, S, NA_HEADS, NA_HEAD_DIM), na_k_g[l])
        v = v.reshape(B, S, NA_HEADS, NA_HEAD_DIM)
        a_out = neighbourhood_attention(q, k, v, na_rpb[l])

        u = short_conv(hy_in, hy_conv_w[l], hy_conv_b[l])
        h_fwd, h_bwd = hyena_filters(pos_z, pos_t, hy_w1[l], hy_b1[l], hy_freq[l],
                                     hy_w2[l], hy_b2[l], hy_w3[l])
        b_out = hyena_mixer(u, h_fwd, h_bwd, hy_bias[l])

        g = jax.nn.sigmoid((gates.reshape(B, S, N_BRANCHES, D) + gate_b[l]).astype(jnp.float32)).astype(x.dtype)
        merged = g[:, :, 0] * (a_out @ w_up_na[l]) + g[:, :, 1] * (b_out @ w_up_hy[l])
        x = x + merged @ w_out[l]
        x = x + peer(rmsnorm(x, norm2_g[l]), peer_wq[l], peer_subkeys[l], peer_u[l], peer_v[l])
    return x
```

```cpp
#include <hip/hip_runtime.h>
#include <hip/hip_cooperative_groups.h>
#include <cstdio>
namespace cg = cooperative_groups;

#ifndef FP4_SWAP
#define FP4_SWAP 0
#endif
#ifndef REPEAT_MASK
#define REPEAT_MASK 0
#endif
#define REPS(k) (1 + ((REPEAT_MASK >> (k)) & 1))
#ifndef ONE_LAUNCH
#define ONE_LAUNCH 1
#endif

#define LAS __attribute__((address_space(3)))
typedef unsigned short bf16_t;
typedef short bf16x8 __attribute__((ext_vector_type(8)));
typedef float f32x4 __attribute__((ext_vector_type(4)));
typedef float f32x2 __attribute__((ext_vector_type(2)));
typedef unsigned u32x4 __attribute__((ext_vector_type(4)));
typedef unsigned u32x2 __attribute__((ext_vector_type(2)));
typedef float c2 __attribute__((ext_vector_type(2)));
typedef int v8i_t __attribute__((ext_vector_type(8)));
__device__ __forceinline__ c2 mk2(float a, float b) { c2 r; r.x = a; r.y = b; return r; }

constexpr int T = 16384, DM = 1024, SEQ = 8192, DEPTH = 4;
constexpr int NTHR = 512;
constexpr int LDS_BYTES = 147456;
constexpr int NFFT = 16384;
constexpr int NPHASE_ = 1 + 7 * 4 + 3;
#ifndef DIAG_TOL
#define DIAG_TOL 0.05f
#endif

constexpr size_t MB = 1024ull * 1024ull;
constexpr size_t WS_WTA = 0;
constexpr size_t WS_WTB = WS_WTA + 24 * MB;
constexpr size_t WS_WNA = WS_WTB + 16 * MB;
constexpr size_t WS_WHY = WS_WNA + 4 * MB;
constexpr size_t WS_WOUT = WS_WHY + 4 * MB;
constexpr size_t WS_WQ = WS_WOUT + 8 * MB;
constexpr size_t WS_SK = WS_WQ + 16 * MB;
constexpr size_t WS_UT = WS_SK + 2 * MB;
constexpr size_t WS_VT = WS_UT + 128 * MB;
constexpr size_t WS_H2 = WS_VT + 128 * MB;
constexpr size_t WS_TW = WS_H2 + 8 * MB;
constexpr size_t WS_HF = WS_TW + 1 * MB;
constexpr size_t WS_XB = WS_HF + 64 * MB;
constexpr size_t WS_QK = WS_XB + 32 * MB;
constexpr size_t WS_GATE = WS_QK + 32 * MB;
constexpr size_t WS_VHT = WS_GATE + 64 * MB;
constexpr size_t WS_AOUT = WS_VHT + 64 * MB;
constexpr size_t WS_BOUT = WS_AOUT + 16 * MB;
constexpr size_t WS_MERGED = WS_BOUT + 16 * MB;
constexpr size_t WS_XMID = WS_MERGED + 32 * MB;
constexpr size_t WS_XBMID = WS_XMID + 64 * MB;
constexpr size_t WS_QPEER = WS_XBMID + 32 * MB;
constexpr size_t WS_TOPK = WS_QPEER + 64 * MB;
constexpr size_t WS_BOUTT = WS_QPEER + 32 * MB;
constexpr size_t WS_BAR = WS_TOPK + 16 * MB;
constexpr size_t WS_END = WS_BAR + 16384;

struct Params {
    const float* in[24];
    float* out;
    unsigned char* ws;
    int ph_lo, ph_hi;
};

__device__ __forceinline__ int otid() { int t = threadIdx.x; asm volatile("" : "+v"(t)); return t; }
typedef const __attribute__((address_space(4))) unsigned char* KArg;
__device__ __forceinline__ Params load_params() {
    KArg k = (KArg)__builtin_amdgcn_kernarg_segment_ptr(); asm volatile("" : "+s"(k));
    Params q;
#pragma unroll
    for (int i = 0; i < 24; ++i) q.in[i] = *(const float* const __attribute__((address_space(4)))*)(k + 8 * i);
    q.out = *(float* const __attribute__((address_space(4)))*)(k + 192);
    q.ws = *(unsigned char* const __attribute__((address_space(4)))*)(k + 200);
    q.ph_lo = 0; q.ph_hi = 0;
    return q;
}
typedef __bf16 bf16x2_t __attribute__((ext_vector_type(2)));
__device__ __forceinline__ unsigned cvt_pk_bf16(float lo, float hi) { f32x2 v; v.x = lo; v.y = hi; const bf16x2_t r = __builtin_convertvector(v, bf16x2_t); return __builtin_bit_cast(unsigned, r); }
__device__ __forceinline__ unsigned pack4_fp8(float a, float b, float c, float d) { int r = 0; r = __builtin_amdgcn_cvt_pk_fp8_f32(a, b, r, false); r = __builtin_amdgcn_cvt_pk_fp8_f32(c, d, r, true); return (unsigned)r; }
__device__ __forceinline__ unsigned pack8_fp4(float a, float b, float c, float d, float e, float f, float g, float h) { unsigned r = 0; r = __builtin_amdgcn_cvt_scalef32_pk_fp4_f32(r, a, b, 1.0f, 0); r = __builtin_amdgcn_cvt_scalef32_pk_fp4_f32(r, c, d, 1.0f, 1); r = __builtin_amdgcn_cvt_scalef32_pk_fp4_f32(r, e, f, 1.0f, 2); r = __builtin_amdgcn_cvt_scalef32_pk_fp4_f32(r, g, h, 1.0f, 3); return r; }
__device__ __forceinline__ float bf_lo(unsigned w) { return __uint_as_float(w << 16); }
__device__ __forceinline__ float bf_hi(unsigned w) { return __uint_as_float(w & 0xffff0000u); }
__device__ __forceinline__ float bf1(bf16_t h) { return __uint_as_float(((unsigned)h) << 16); }
__device__ __forceinline__ unsigned fmap(float f) { unsigned u = __float_as_uint(f); return u ^ ((u >> 31) ? 0xFFFFFFFFu : 0x80000000u); }
__device__ __forceinline__ float funmap(unsigned k) { return __uint_as_float(k ^ ((k >> 31) ? 0x80000000u : 0xFFFFFFFFu)); }
__device__ __forceinline__ float wave_sum(float v) {
#pragma unroll
    for (int o = 32; o >= 1; o >>= 1) v += __shfl_xor(v, o);
    return v;
}

namespace pg8 {
constexpr int BM = 256, BK = 64, HALF = 128, HTB = HALF * BK * 2, STAGE_BYTES = 8 * HTB, NXCD = 8, WGM = 8;
__host__ __device__ __forceinline__ int lds_byte(int r, int c) { const int st = (r >> 4) * 2 + (c >> 5), rr = r & 15, cc = c & 31, ob = rr * 64 + cc * 2; return st * 1024 + (ob ^ (((ob >> 9) & 1) << 5)); }
__host__ __device__ __forceinline__ void stage_rc(int b, int& R, int& C) { const int st = b / 1024, sb = b % 1024, swz = sb ^ (((sb >> 9) & 1) << 5); R = (st >> 1) * 16 + swz / 64; C = (st & 1) * 32 + (swz % 64) / 2; }
__host__ __device__ __forceinline__ int perm32(int rho) { const int n = rho >> 4, i = rho & 15; return 8 * (i >> 2) + 4 * n + (i & 3); }
struct Unit { int pm, pn; };
struct Gemm { const bf16_t* A; const bf16_t* Bt; int M, N, K; };
struct StaticOrder {
    int nM, nN, nwg, G, c;
    __host__ __device__ void init(int M, int N, int G_, int c_) { nM = M / BM; nN = N / BM; nwg = nM * nN; G = G_; c = c_; }
    __host__ __device__ bool next(int i, Unit& u) const {
        const long L = (long)i * G + c; if (L >= nwg) return false;
        int wgid = (int)L; { const int q = nwg / NXCD, r = nwg % NXCD, xcd = wgid % NXCD, off = wgid / NXCD; wgid = (xcd < r ? xcd * (q + 1) : r * (q + 1) + (xcd - r) * q) + off; }
        const int nig = WGM * nN, gid = wgid / nig, fm = gid * WGM, gsz = (nM - fm) < WGM ? (nM - fm) : WGM;
        u.pm = fm + ((wgid % nig) % gsz); u.pn = (wgid % nig) / gsz; return true;
    }
};

template <class Epi>
__device__ __forceinline__ void gemm_phase(LAS unsigned char* lds, const Gemm g, const StaticOrder& S, const Epi& E) {
    const int tid = otid(), wid = __builtin_amdgcn_readfirstlane(tid >> 6), lane = tid & 63, wr = wid >> 2, wc = wid & 3, fr = lane & 15, fq = lane >> 4;
    const int K = g.K, nt = K / BK;
    unsigned voffA[2], voffB[2];
#pragma unroll
    for (int i = 0; i < 2; ++i) { int R, C; stage_rc(tid * 16 + i * 8192, R, C); const int Rb = Epi::PERM ? ((R & ~31) + perm32(R & 31)) : R;
        voffA[i] = (unsigned)(R * K + C) * 2u; voffB[i] = (unsigned)(Rb * K + C) * 2u; }
    const size_t kstep = (size_t)(BK * 2);
    const size_t hstep = (size_t)HALF * K * 2;
    const size_t tstep = 2 * hstep;
    const unsigned ldsw = (unsigned)wid * 1024u;
    const int aoff = lds_byte(wr * 64 + fr, fq * 8), boff = lds_byte(wc * 32 + fr, fq * 8);
#define PG8_SA(b, h) (((b) * 2 + (h)) * HTB)
#define PG8_SB(b, h) ((4 + (b) * 2 + (h)) * HTB)
#define PG8_STAGE(bufoff, gbase, voff) do { _Pragma("unroll") for (int _i = 0; _i < 2; ++_i) \
        __builtin_amdgcn_global_load_lds((const unsigned*)((const char*)(gbase) + (voff)[_i]), (LAS unsigned*)(lds + (bufoff) + ldsw + _i * 8192), 16, 0, 0); } while (0)
#define PG8_LDA(dst, b, h) do { _Pragma("unroll") for (int m = 0; m < 4; ++m) _Pragma("unroll") for (int k = 0; k < 2; ++k) dst[m][k] = *(const LAS bf16x8*)(lds + PG8_SA(b, h) + aoff + m * 2048 + k * 1024); } while (0)
#define PG8_LDB(dst, b, h) do { _Pragma("unroll") for (int n = 0; n < 2; ++n) _Pragma("unroll") for (int k = 0; k < 2; ++k) dst[n][k] = *(const LAS bf16x8*)(lds + PG8_SB(b, h) + boff + n * 2048 + k * 1024); } while (0)
#define PG8_MMA(ai, bj, At, Bt) do { __builtin_amdgcn_s_setprio(1); _Pragma("unroll") for (int m = 0; m < 4; ++m) _Pragma("unroll") for (int n = 0; n < 2; ++n) _Pragma("unroll") for (int k = 0; k < 2; ++k) \
        acc[ai][bj][m][n] = __builtin_amdgcn_mfma_f32_16x16x32_bf16(Bt[n][k], At[m][k], acc[ai][bj][m][n], 0, 0, 0); __builtin_amdgcn_s_setprio(0); } while (0)
#define PG8_WAIT_V(n) asm volatile("s_waitcnt vmcnt(" #n ")" ::: "memory")
#define PG8_WAIT_L(n) asm volatile("s_waitcnt lgkmcnt(" #n ")" ::: "memory")
#define PG8_BAR __builtin_amdgcn_s_barrier()
#define PG8_SCHED __builtin_amdgcn_sched_barrier(0)
    Unit cur, nxt; int ui = 0;
    if (!S.next(0, cur)) return;
    f32x4 acc[2][2][4][2];
#pragma unroll
    for (int a = 0; a < 2; ++a)
#pragma unroll
        for (int b = 0; b < 2; ++b)
#pragma unroll
            for (int m = 0; m < 4; ++m)
#pragma unroll
                for (int n = 0; n < 2; ++n) acc[a][b][m][n] = (f32x4){0.f, 0.f, 0.f, 0.f};
    bf16x8 At[4][2], B0[2][2], B1[2][2];
    const char* cA = (const char*)g.A + (size_t)cur.pm * tstep; const char* cB = (const char*)g.Bt + (size_t)cur.pn * tstep;
    PG8_STAGE(PG8_SB(0, 0), cB, voffB); PG8_STAGE(PG8_SA(0, 0), cA, voffA); PG8_STAGE(PG8_SB(0, 1), cB + hstep, voffB); PG8_STAGE(PG8_SA(0, 1), cA + hstep, voffA);
    if (wr == 1) PG8_BAR;
    PG8_WAIT_V(4); PG8_BAR;
    PG8_STAGE(PG8_SB(1, 0), cB + kstep, voffB); PG8_STAGE(PG8_SA(1, 0), cA + kstep, voffA); PG8_STAGE(PG8_SB(1, 1), cB + hstep + kstep, voffB);
    PG8_WAIT_V(6); PG8_BAR;
    for (;;) {
        const bool has_next = S.next(ui + 1, nxt);
        const char* nA = has_next ? (const char*)g.A + (size_t)nxt.pm * tstep : cA; const char* nB = has_next ? (const char*)g.Bt + (size_t)nxt.pn * tstep : cB;
        for (int t = 0; t < nt; t += 2) {
            const bool last = (t == nt - 2);
            const char* a1 = cA + (size_t)(t + 1) * kstep;
            const char* a2 = last ? nA : cA + (size_t)(t + 2) * kstep; const char* b2 = last ? nB : cB + (size_t)(t + 2) * kstep;
            const char* a3 = a2 + kstep; const char* b3 = b2 + kstep;
            PG8_LDB(B0, 0, 0); PG8_SCHED; PG8_LDA(At, 0, 0); PG8_STAGE(PG8_SA(1, 1), a1 + hstep, voffA);
            PG8_WAIT_L(8); PG8_BAR; PG8_WAIT_L(0); PG8_MMA(0, 0, At, B0); PG8_BAR; PG8_SCHED;
            PG8_LDB(B1, 0, 1); PG8_STAGE(PG8_SB(0, 0), b2, voffB);
            PG8_BAR; PG8_WAIT_L(0); PG8_MMA(0, 1, At, B1); PG8_BAR;
            PG8_LDA(At, 0, 1); PG8_STAGE(PG8_SA(0, 0), a2, voffA);
            PG8_BAR; PG8_WAIT_L(0); PG8_MMA(1, 0, At, B0); PG8_BAR; PG8_SCHED;
            PG8_STAGE(PG8_SB(0, 1), b2 + hstep, voffB);
            PG8_WAIT_V(6); PG8_BAR; PG8_MMA(1, 1, At, B1); PG8_BAR;
            PG8_LDB(B0, 1, 0); PG8_SCHED; PG8_LDA(At, 1, 0); PG8_STAGE(PG8_SA(0, 1), a2 + hstep, voffA);
            PG8_WAIT_L(8); PG8_BAR; PG8_WAIT_L(0); PG8_MMA(0, 0, At, B0); PG8_BAR; PG8_SCHED;
            PG8_LDB(B1, 1, 1); PG8_STAGE(PG8_SB(1, 0), b3, voffB);
            PG8_BAR; PG8_WAIT_L(0); PG8_MMA(0, 1, At, B1); PG8_BAR;
            PG8_LDA(At, 1, 1); PG8_STAGE(PG8_SA(1, 0), a3, voffA);
            PG8_BAR; PG8_WAIT_L(0); PG8_MMA(1, 0, At, B0); PG8_BAR; PG8_SCHED;
            PG8_STAGE(PG8_SB(1, 1), b3 + hstep, voffB);
            PG8_WAIT_V(6); PG8_BAR; PG8_MMA(1, 1, At, B1); PG8_BAR;
        }
        E(acc, cur, wr, wc, fr, fq);
        if (!has_next) break;
#pragma unroll
        for (int a = 0; a < 2; ++a)
#pragma unroll
            for (int b = 0; b < 2; ++b)
#pragma unroll
                for (int m = 0; m < 4; ++m)
#pragma unroll
                    for (int n = 0; n < 2; ++n) acc[a][b][m][n] = (f32x4){0.f, 0.f, 0.f, 0.f};
        cur = nxt; cA = nA; cB = nB; ++ui;
    }
    PG8_WAIT_V(0);
    if (wr == 0) PG8_BAR;
    PG8_BAR;
#undef PG8_SA
#undef PG8_SB
#undef PG8_STAGE
#undef PG8_LDA
#undef PG8_LDB
#undef PG8_MMA
#undef PG8_WAIT_V
#undef PG8_WAIT_L
#undef PG8_BAR
#undef PG8_SCHED
}

struct EpiBf16 {
    static constexpr bool PERM = true;
    bf16_t* O; int ldc;
    __device__ __forceinline__ void operator()(const f32x4 (&acc)[2][2][4][2], const Unit& u, int wr, int wc, int fr, int fq) const {
        const int row0 = u.pm * BM + wr * 64 + fr, col0 = u.pn * BM + wc * 32 + 8 * fq;
#pragma unroll
        for (int ai = 0; ai < 2; ++ai)
#pragma unroll
            for (int m = 0; m < 4; ++m) { bf16_t* rowp = O + (size_t)(row0 + ai * HALF + m * 16) * ldc + col0;
#pragma unroll
                for (int bj = 0; bj < 2; ++bj) { const f32x4 v0 = acc[ai][bj][m][0], v1 = acc[ai][bj][m][1];
                    u32x4 w; w.x = cvt_pk_bf16(v0[0], v0[1]); w.y = cvt_pk_bf16(v0[2], v0[3]); w.z = cvt_pk_bf16(v1[0], v1[1]); w.w = cvt_pk_bf16(v1[2], v1[3]);
                    *(u32x4*)(rowp + bj * HALF) = w; } }
    }
};
struct EpiQKG {
    static constexpr bool PERM = true;
    bf16_t* QKo; bf16_t* GATE; const float* gb;
    __device__ __forceinline__ void operator()(const f32x4 (&acc)[2][2][4][2], const Unit& u, int wr, int wc, int fr, int fq) const {
        const int row0 = u.pm * BM + wr * 64 + fr, col0 = u.pn * BM + wc * 32 + 8 * fq;
        if (u.pn < 4) {
#pragma unroll
            for (int ai = 0; ai < 2; ++ai)
#pragma unroll
                for (int m = 0; m < 4; ++m) { bf16_t* rowp = QKo + (size_t)(row0 + ai * HALF + m * 16) * 1024 + col0;
#pragma unroll
                    for (int bj = 0; bj < 2; ++bj) { const f32x4 v0 = acc[ai][bj][m][0], v1 = acc[ai][bj][m][1];
                        u32x4 w; w.x = cvt_pk_bf16(v0[0], v0[1]); w.y = cvt_pk_bf16(v0[2], v0[3]); w.z = cvt_pk_bf16(v1[0], v1[1]); w.w = cvt_pk_bf16(v1[2], v1[3]);
                        *(u32x4*)(rowp + bj * HALF) = w; } }
        } else {
            const int gc = col0 - 1024;
            f32x4 bv[2][2];
#pragma unroll
            for (int bj = 0; bj < 2; ++bj)
#pragma unroll
                for (int n = 0; n < 2; ++n) bv[bj][n] = *(const f32x4*)(gb + gc + bj * HALF + 4 * n);
#pragma unroll
            for (int ai = 0; ai < 2; ++ai)
#pragma unroll
                for (int m = 0; m < 4; ++m) { bf16_t* rowp = GATE + (size_t)(row0 + ai * HALF + m * 16) * 2048 + gc;
#pragma unroll
                    for (int bj = 0; bj < 2; ++bj) { f32x4 v0 = acc[ai][bj][m][0] + bv[bj][0], v1 = acc[ai][bj][m][1] + bv[bj][1];
#pragma unroll
                        for (int j = 0; j < 4; ++j) {
#ifndef DIAG_RAWGATE
 v0[j] = __builtin_amdgcn_rcpf(1.f + __expf(-v0[j])); v1[j] = __builtin_amdgcn_rcpf(1.f + __expf(-v1[j]));
#endif
 }
                        u32x4 w; w.x = cvt_pk_bf16(v0[0], v0[1]); w.y = cvt_pk_bf16(v0[2], v0[3]); w.z = cvt_pk_bf16(v1[0], v1[1]); w.w = cvt_pk_bf16(v1[2], v1[3]);
                        *(u32x4*)(rowp + bj * HALF) = w; } }
        }
    }
};
struct EpiUpA {
    static constexpr bool PERM = false;
    bf16_t* TMP; const bf16_t* GATE;
    __device__ __forceinline__ void operator()(const f32x4 (&acc)[2][2][4][2], const Unit& u, int wr, int wc, int fr, int fq) const {
        const int row0 = u.pm * BM + wr * 64 + fr, col0 = u.pn * BM + wc * 32 + 4 * fq;
#pragma unroll
        for (int ai = 0; ai < 2; ++ai)
#pragma unroll
            for (int m = 0; m < 4; ++m) { const size_t row = (size_t)(row0 + ai * HALF + m * 16);
#pragma unroll
                for (int bj = 0; bj < 2; ++bj)
#pragma unroll
                    for (int n = 0; n < 2; ++n) { const int col = col0 + bj * HALF + n * 16;
                        const u32x2 gw = *(const u32x2*)(GATE + row * 2048 + col);
                        f32x4 v = acc[ai][bj][m][n]; v[0] *= bf_lo(gw.x); v[1] *= bf_hi(gw.x); v[2] *= bf_lo(gw.y); v[3] *= bf_hi(gw.y);
                        u32x2 w; w.x = cvt_pk_bf16(v[0], v[1]); w.y = cvt_pk_bf16(v[2], v[3]);
                        *(u32x2*)(TMP + row * 1024 + col) = w; } }
    }
};
struct EpiUpB {
    static constexpr bool PERM = false;
    const bf16_t* TMP; const bf16_t* GATE; bf16_t* MERGED;
    __device__ __forceinline__ void operator()(const f32x4 (&acc)[2][2][4][2], const Unit& u, int wr, int wc, int fr, int fq) const {
        const int row0 = u.pm * BM + wr * 64 + fr, col0 = u.pn * BM + wc * 32 + 4 * fq;
#pragma unroll
        for (int ai = 0; ai < 2; ++ai)
#pragma unroll
            for (int m = 0; m < 4; ++m) { const size_t row = (size_t)(row0 + ai * HALF + m * 16);
#pragma unroll
                for (int bj = 0; bj < 2; ++bj)
#pragma unroll
                    for (int n = 0; n < 2; ++n) { const int col = col0 + bj * HALF + n * 16;
                        const u32x2 gw = *(const u32x2*)(GATE + row * 2048 + 1024 + col);
                        const u32x2 tw = *(const u32x2*)(TMP + row * 1024 + col); const f32x4 t = (f32x4){bf_lo(tw.x), bf_hi(tw.x), bf_lo(tw.y), bf_hi(tw.y)};
                        f32x4 v = acc[ai][bj][m][n]; v[0] = t[0] + v[0] * bf_lo(gw.x); v[1] = t[1] + v[1] * bf_hi(gw.x); v[2] = t[2] + v[2] * bf_lo(gw.y); v[3] = t[3] + v[3] * bf_hi(gw.y);
                        u32x2 w; w.x = cvt_pk_bf16(v[0], v[1]); w.y = cvt_pk_bf16(v[2], v[3]);
                        *(u32x2*)(MERGED + row * 1024 + col) = w; } }
    }
};
struct EpiOut {
    static constexpr bool PERM = false;
    const float* XRES; float* XMID; bf16_t* XBMID;
    __device__ __forceinline__ void operator()(const f32x4 (&acc)[2][2][4][2], const Unit& u, int wr, int wc, int fr, int fq) const {
        const int row0 = u.pm * BM + wr * 64 + fr, col0 = u.pn * BM + wc * 32 + 4 * fq;
#pragma unroll
        for (int ai = 0; ai < 2; ++ai)
#pragma unroll
            for (int m = 0; m < 4; ++m) { const size_t row = (size_t)(row0 + ai * HALF + m * 16);
#pragma unroll
                for (int bj = 0; bj < 2; ++bj)
#pragma unroll
                    for (int n = 0; n < 2; ++n) { const int col = col0 + bj * HALF + n * 16;
                        const f32x4 v = acc[ai][bj][m][n] + *(const f32x4*)(XRES + row * 1024 + col);
                        *(f32x4*)(XMID + row * 1024 + col) = v;
                        u32x2 w; w.x = cvt_pk_bf16(v[0], v[1]); w.y = cvt_pk_bf16(v[2], v[3]);
                        *(u32x2*)(XBMID + row * 1024 + col) = w; } }
    }
};
}

__device__ __forceinline__ void p0_transpose_tile(LAS float* tile, const float* __restrict__ src, int ldsrc, int col0, int k0, const float* __restrict__ scale,
                                  bf16_t* __restrict__ dst, int K, int drow0) {
    const int tid = otid();
    {
        const int kk = tid >> 4, nn = (tid & 15) * 4;
#pragma unroll
        for (int i = 0; i < 2; ++i) {
            const int k = kk + 32 * i;
            const f32x4 v = *(const f32x4*)(src + (size_t)(k0 + k) * ldsrc + col0 + nn);
            const float sc = scale ? scale[k0 + k] : 1.f;
            tile[k * 65 + nn + 0] = v[0] * sc; tile[k * 65 + nn + 1] = v[1] * sc; tile[k * 65 + nn + 2] = v[2] * sc; tile[k * 65 + nn + 3] = v[3] * sc;
        }
    }
    __syncthreads();
    {
        const int n = tid >> 3, kc = (tid & 7) * 8;
        float a[8];
#pragma unroll
        for (int j = 0; j < 8; ++j) a[j] = tile[(kc + j) * 65 + n];
        u32x4 w; w.x = cvt_pk_bf16(a[0], a[1]); w.y = cvt_pk_bf16(a[2], a[3]); w.z = cvt_pk_bf16(a[4], a[5]); w.w = cvt_pk_bf16(a[6], a[7]);
        *(u32x4*)(dst + (size_t)(drow0 + n) * K + k0 + kc) = w;
    }
    __syncthreads();
}

__device__ __forceinline__ void p0_prologue(const Params& p, LAS unsigned char* lds) {
    const int tid = otid(), lane = tid & 63, G = gridDim.x;
    unsigned char* ws = p.ws;
    for (int t = blockIdx.x; t < 4 * 2304; t += G) {
        const int l = t / 2304; int r = t % 2304;
        const float* src; int ldsrc, scol0, K; const float* scale; bf16_t* dst; int drow0;
        if (r < 256) { src = p.in[2] + (size_t)l * 1024 * 5120; ldsrc = 5120; scol0 = 0; K = 1024; scale = p.in[1] + l * 1024; dst = (bf16_t*)(ws + WS_WTA) + (size_t)l * 3072 * 1024; drow0 = 0; }
        else if (r < 768) { r -= 256; src = p.in[2] + (size_t)l * 1024 * 5120; ldsrc = 5120; scol0 = 3072; K = 1024; scale = p.in[1] + l * 1024; dst = (bf16_t*)(ws + WS_WTA) + (size_t)l * 3072 * 1024; drow0 = 1024; }
        else if (r < 1280) { r -= 768; src = p.in[2] + (size_t)l * 1024 * 5120; ldsrc = 5120; scol0 = 1024; K = 1024; scale = p.in[1] + l * 1024; dst = (bf16_t*)(ws + WS_WTB) + (size_t)l * 2048 * 1024; drow0 = 0; }
        else if (r < 1408) { r -= 1280; src = p.in[16] + (size_t)l * 512 * 1024; ldsrc = 1024; scol0 = 0; K = 512; scale = nullptr; dst = (bf16_t*)(ws + WS_WNA) + (size_t)l * 1024 * 512; drow0 = 0; }
        else if (r < 1536) { r -= 1408; src = p.in[17] + (size_t)l * 512 * 1024; ldsrc = 1024; scol0 = 0; K = 512; scale = nullptr; dst = (bf16_t*)(ws + WS_WHY) + (size_t)l * 1024 * 512; drow0 = 0; }
        else if (r < 1792) { r -= 1536; src = p.in[18] + (size_t)l * 1024 * 1024; ldsrc = 1024; scol0 = 0; K = 1024; scale = nullptr; dst = (bf16_t*)(ws + WS_WOUT) + (size_t)l * 1024 * 1024; drow0 = 0; }
        else { r -= 1792; src = p.in[20] + (size_t)l * 1024 * 2048; ldsrc = 2048; scol0 = 0; K = 1024; scale = p.in[19] + l * 1024; dst = (bf16_t*)(ws + WS_WQ) + (size_t)l * 2048 * 1024; drow0 = 0; }
        const int nkt = K / 64, tk = r % nkt, tn = r / nkt;
        p0_transpose_tile((LAS float*)lds, src, ldsrc, scol0 + tn * 64, tk * 64, scale, dst, K, drow0 + tn * 64);
    }
    const size_t gt = (size_t)blockIdx.x * NTHR + tid, gstride = (size_t)G * NTHR;
    {
        const float* src = p.in[21]; bf16_t* dst = (bf16_t*)(ws + WS_SK);
        for (size_t i = gt; i < (size_t)4 * 262144 / 8; i += gstride) {
            const f32x4 a = *(const f32x4*)(src + i * 8), b = *(const f32x4*)(src + i * 8 + 4);
            u32x4 w; w.x = cvt_pk_bf16(a[0], a[1]); w.y = cvt_pk_bf16(a[2], a[3]); w.z = cvt_pk_bf16(b[0], b[1]); w.w = cvt_pk_bf16(b[2], b[3]);
            *(u32x4*)(dst + i * 8) = w;
        }
    }
#pragma unroll 1
    for (int tb = 0; tb < 2; ++tb) {
        const float* src = tb ? p.in[23] : p.in[22]; unsigned char* dst = ws + (tb ? WS_VT : WS_UT);
        for (size_t i = gt; i < (size_t)4 * 16384 * 1024 / 16; i += gstride) {
            f32x4 a[4];
#pragma unroll
            for (int q = 0; q < 4; ++q) a[q] = __builtin_nontemporal_load((const f32x4*)(src + i * 16 + q * 4)) * 64.f;
            u32x2 w;
            if (tb == 0 && FP4_SWAP) { w.x = pack8_fp4(a[0][1], a[0][0], a[0][3], a[0][2], a[1][1], a[1][0], a[1][3], a[1][2]); w.y = pack8_fp4(a[2][1], a[2][0], a[2][3], a[2][2], a[3][1], a[3][0], a[3][3], a[3][2]); }
            else { w.x = pack8_fp4(a[0][0], a[0][1], a[0][2], a[0][3], a[1][0], a[1][1], a[1][2], a[1][3]); w.y = pack8_fp4(a[2][0], a[2][1], a[2][2], a[2][3], a[3][0], a[3][1], a[3][2], a[3][3]); }
            *(u32x2*)(dst + i * 8) = w;
        }
    }
    const int gw = blockIdx.x * 8 + (tid >> 6), nw = G * 8;
    {
        const float* x = p.in[0]; bf16_t* xb = (bf16_t*)(ws + WS_XB);
        for (int tok = gw; tok < T; tok += nw) {
            const float* xr = x + (size_t)tok * 1024;
            f32x4 v[4]; float ss = 0.f;
#pragma unroll
            for (int i = 0; i < 2; ++i) { v[2 * i] = *(const f32x4*)(xr + i * 512 + lane * 8); v[2 * i + 1] = *(const f32x4*)(xr + i * 512 + lane * 8 + 4); }
#pragma unroll
            for (int i = 0; i < 4; ++i) ss += v[i][0] * v[i][0] + v[i][1] * v[i][1] + v[i][2] * v[i][2] + v[i][3] * v[i][3];
            ss = wave_sum(ss);
            const float rs = rsqrtf(ss * (1.f / 1024.f) + 1e-6f);
#pragma unroll
            for (int i = 0; i < 2; ++i) { const f32x4 a = v[2 * i] * rs, b = v[2 * i + 1] * rs;
                u32x4 w; w.x = cvt_pk_bf16(a[0], a[1]); w.y = cvt_pk_bf16(a[2], a[3]); w.z = cvt_pk_bf16(b[0], b[1]); w.w = cvt_pk_bf16(b[2], b[3]);
                *(u32x4*)(xb + (size_t)tok * 1024 + i * 512 + lane * 8) = w; }
        }
    }
    {
        float* H2 = (float*)(ws + WS_H2);
        for (int row = gw; row < 4 * SEQ; row += nw) {
            const int l = row / SEQ, s = row % SEQ;
            const float tt = (float)s * (1.f / 8191.f);
            const float w = 6.283185307179586f * (float)s / 8192.f;
            float z = 0.f;
            if (lane == 0) z = tt;
            else if (lane <= 16) { const float f = 1e-4f + (float)(lane - 1) * ((15.f - 1e-4f) / 15.f); z = cosf(f * w); }
            else if (lane <= 32) { const float f = 1e-4f + (float)(lane - 17) * ((15.f - 1e-4f) / 15.f); z = -sinf(f * w); }
            const float* w1 = p.in[9] + (size_t)l * 33 * 64; const float* w2 = p.in[12] + (size_t)l * 64 * 64;
            const float fr = p.in[11][l * 64 + lane];
            float a = p.in[10][l * 64 + lane];
            for (int i = 0; i < 33; ++i) a += __shfl(z, i) * w1[i * 64 + lane];
            const float h1 = sinf(fr * a);
            float a2 = p.in[13][l * 64 + lane];
            for (int i = 0; i < 64; ++i) a2 += __shfl(h1, i) * w2[i * 64 + lane];
            H2[(size_t)row * 64 + lane] = sinf(fr * a2);
        }
    }
    {
        c2* tw = (c2*)(ws + WS_TW);
        for (size_t k = gt; k < NFFT; k += gstride) { float s, c; sincospif((float)k * (1.f / 8192.f), &s, &c); tw[k] = mk2(c, -s); }
    }
}

__device__ __forceinline__ c2 cadd(c2 a, c2 b) { return a + b; }
__device__ __forceinline__ c2 csub(c2 a, c2 b) { return a - b; }
__device__ __forceinline__ c2 cmul(c2 a, c2 b) { const c2 ax = {a.x, a.x}, ay = {a.y, a.y}, bs = {-b.y, b.x}; return __builtin_elementwise_fma(ay, bs, ax * b); }
__device__ __forceinline__ c2 cmulc(c2 a, c2 b) { const c2 ax = {a.x, a.x}, ay = {a.y, a.y}, bc = {b.x, -b.y}, bs = {b.y, b.x}; return __builtin_elementwise_fma(ay, bs, ax * bc); }
__device__ __forceinline__ int sw(int p) { return p ^ (((p >> 5) & 3) * 5) ^ (((p >> 6) & 1) << 4); }
__device__ __forceinline__ int rev4_14(int p) { unsigned r = __brev((unsigned)p) >> 18; return (int)(((r & 0x1555u) << 1) | ((r >> 1) & 0x1555u)); }

template <bool ZEROHI, bool SKIPLAST = false>
__device__ __forceinline__ void fft_fwd(LAS c2* X, const LAS c2* TWL) {
    const int tid = otid();
#pragma unroll
    for (int lg = 14; lg >= 2; lg -= 2) {
        if (SKIPLAST && lg == 2) break;
        const int q = 1 << (lg - 2), tsh = 14 - lg;
#pragma unroll 2
        for (int i = 0; i < 8; ++i) {
            const int t = tid + 512 * i, j = t & (q - 1), base = ((t >> (lg - 2)) << lg) + j;
            const bool zhi = ZEROHI && lg == 14;
            const int i0 = sw(base), i1 = sw(base + q), i2 = sw(base + 2 * q), i3 = sw(base + 3 * q);
            const c2 a0 = X[i0], a1 = X[i1], a2 = zhi ? mk2(0.f, 0.f) : X[i2], a3 = zhi ? mk2(0.f, 0.f) : X[i3];
            const c2 b0 = cadd(a0, a2), b1 = csub(a0, a2), b2 = cadd(a1, a3), d = csub(a1, a3);
            const c2 b3 = mk2(d.y, -d.x);
            const int k1 = j << tsh; const c2 w1 = cmul(TWL[k1 >> 7], TWL[128 + (k1 & 127)]), w2 = cmul(w1, w1), w3 = cmul(w2, w1);
            X[i0] = cadd(b0, b2); X[i1] = cmul(cadd(b1, b3), w1); X[i2] = cmul(csub(b0, b2), w2); X[i3] = cmul(csub(b1, b3), w3);
        }
        __syncthreads();
    }
}
template <bool LOHALF, bool SKIPFIRST = false>
__device__ __forceinline__ void fft_inv(LAS c2* X, const LAS c2* TWL) {
    const int tid = otid();
#pragma unroll
    for (int lg = 2; lg <= 14; lg += 2) {
        if (SKIPFIRST && lg == 2) continue;
        const int q = 1 << (lg - 2), tsh = 14 - lg;
#pragma unroll 2
        for (int i = 0; i < 8; ++i) {
            const int t = tid + 512 * i, j = t & (q - 1), base = ((t >> (lg - 2)) << lg) + j;
            const int k1 = j << tsh; const c2 w1 = cmul(TWL[k1 >> 7], TWL[128 + (k1 & 127)]), w2 = cmul(w1, w1), w3 = cmul(w2, w1);
            const int i0 = sw(base), i1 = sw(base + q), i2 = sw(base + 2 * q), i3 = sw(base + 3 * q);
            const c2 a0 = X[i0], a1 = cmulc(X[i1], w1), a2 = cmulc(X[i2], w2), a3 = cmulc(X[i3], w3);
            const c2 b0 = cadd(a0, a2), b1 = csub(a0, a2), b2 = cadd(a1, a3), d = csub(a1, a3);
            const c2 b3 = mk2(-d.y, d.x);
            X[i0] = cadd(b0, b2); X[i1] = cadd(b1, b3);
            if (!(LOHALF && lg == 14)) { X[i2] = csub(b0, b2); X[i3] = csub(b1, b3); }
        }
        __syncthreads();
    }
}

__device__ __forceinline__ void filter_item(const Params& p, LAS unsigned char* lds, int l, int pair) {
    const int tid = otid();
    LAS c2* X = (LAS c2*)lds;
    LAS float* wc = (LAS float*)(lds + 131072);
    const c2* tw = (const c2*)(p.ws + WS_TW);
    const float* H2 = (const float*)(p.ws + WS_H2) + (size_t)l * SEQ * 64;
    const float* w3 = p.in[14] + (size_t)l * 64 * 1024;
    const int c0 = pair * 2, c1 = c0 + 1;
    if (tid < 256) { const int q = tid >> 6, j = tid & 63; const int col = (q == 0) ? c0 : (q == 1 ? 512 + c0 : (q == 2 ? c1 : 512 + c1)); wc[tid] = w3[j * 1024 + col]; }
    LAS c2* TWL = (LAS c2*)(lds + 131072 + 1024);
    if (tid < 256) TWL[tid] = tw[tid < 128 ? tid * 128 : tid - 128];
    __syncthreads();
    const float mind = -3.0701134573253945f, maxd = -15.350567286626972f;
    const float ad0 = fabsf(mind + (maxd - mind) * ((float)c0 / 511.f)), ad1 = fabsf(mind + (maxd - mind) * ((float)c1 / 511.f));
    const float invN = 1.f / 16384.f;
    const float sk0 = p.in[15][l * 512 + c0], sk1 = p.in[15][l * 512 + c1];
    {
        const int lane = tid & 63, wv = tid >> 6, n = lane & 15, g = lane >> 4, q = n & 3, rr = n >> 2;
        LAS float* Xf = (LAS float*)X;
        bf16x8 bfr[2];
#pragma unroll
        for (int ks = 0; ks < 2; ++ks) { float wv8[8];
#pragma unroll
            for (int e = 0; e < 8; ++e) wv8[e] = wc[q * 64 + ks * 32 + g * 8 + e];
            u32x4 w; w.x = cvt_pk_bf16(wv8[0], wv8[1]); w.y = cvt_pk_bf16(wv8[2], wv8[3]); w.z = cvt_pk_bf16(wv8[4], wv8[5]); w.w = cvt_pk_bf16(wv8[6], wv8[7]); bfr[ks] = __builtin_bit_cast(bf16x8, w); }
        const float adq = (q < 2) ? ad0 : ad1;
        const float kexp = -adq * (1.f / 8191.f) * 1.4426950408889634f;
        const int comp = q >> 1;
        const bool bwd = (q & 1) != 0;
#pragma unroll 2
        for (int t = 0; t < 64; ++t) {
            const int s0 = wv * 1024 + t * 16;
            const float* hp = H2 + (size_t)(s0 + n) * 64 + g * 8;
            const f32x4 h0 = *(const f32x4*)hp, h1 = *(const f32x4*)(hp + 4), h2v = *(const f32x4*)(hp + 32), h3 = *(const f32x4*)(hp + 36);
            u32x4 a0, a1;
            a0.x = cvt_pk_bf16(h0[0], h0[1]); a0.y = cvt_pk_bf16(h0[2], h0[3]); a0.z = cvt_pk_bf16(h1[0], h1[1]); a0.w = cvt_pk_bf16(h1[2], h1[3]);
            a1.x = cvt_pk_bf16(h2v[0], h2v[1]); a1.y = cvt_pk_bf16(h2v[2], h2v[3]); a1.z = cvt_pk_bf16(h3[0], h3[1]); a1.w = cvt_pk_bf16(h3[2], h3[3]);
            f32x4 acc = (f32x4){0.f, 0.f, 0.f, 0.f};
            acc = __builtin_amdgcn_mfma_f32_16x16x32_bf16(__builtin_bit_cast(bf16x8, a0), bfr[0], acc, 0, 0, 0);
            acc = __builtin_amdgcn_mfma_f32_16x16x32_bf16(__builtin_bit_cast(bf16x8, a1), bfr[1], acc, 0, 0, 0);
            const float v = (rr == 0) ? acc[0] : (rr == 1 ? acc[1] : (rr == 2 ? acc[2] : acc[3]));
            const int sp = s0 + g * 4 + rr;
            const float val = v * __builtin_amdgcn_exp2f(kexp * (float)sp) * invN;
            if (!bwd) Xf[2 * sw(sp) + comp] = val;
            else if (sp != 0) Xf[2 * sw(NFFT - sp) + comp] = val;
            else wc[768 + comp] = val;
        }
    }
    __syncthreads();
    if (tid == 0) { const c2 x0 = X[0]; X[0] = mk2(x0.x + wc[768] + sk0 * invN, x0.y + wc[769] + sk1 * invN); }
    if (tid == 0) X[8192] = mk2(0.f, 0.f);
    __syncthreads();
    fft_fwd<false>(X, TWL);
    c2* HF0 = (c2*)(p.ws + WS_HF) + (size_t)c0 * NFFT; c2* HF1 = HF0 + NFFT;
#pragma unroll 1
    for (int ii = 0; ii < 32; ++ii) {
        const int pp = tid + 512 * ii;
        const int k = rev4_14(pp), pm = rev4_14((NFFT - k) & (NFFT - 1));
        const c2 W1 = X[sw(pp)], W2 = X[sw(pm)];
        __builtin_nontemporal_store(mk2(0.5f * (W1.x + W2.x), 0.5f * (W1.y - W2.y)), HF0 + pp);
        __builtin_nontemporal_store(mk2(0.5f * (W1.y + W2.y), -0.5f * (W1.x - W2.x)), HF1 + pp);
    }
    __syncthreads();
}

struct Conv8In { u32x4 v; bf16_t lo, hi; };
__device__ __forceinline__ Conv8In conv8_load(const bf16_t* __restrict__ row, int b, int s0) {
    const bf16_t* rp = row + (size_t)b * SEQ + s0;
    Conv8In r; r.v = *(const u32x4*)rp; r.lo = (s0 == 0) ? (bf16_t)0 : rp[-1]; r.hi = (s0 + 8 == SEQ) ? (bf16_t)0 : rp[8];
    return r;
}
__device__ __forceinline__ void conv8_apply(const Conv8In& in, float w0, float w1, float w2, float bias, float (&o)[8]) {
    float x[10];
    x[0] = bf1(in.lo); x[9] = bf1(in.hi);
    x[1] = bf_lo(in.v.x); x[2] = bf_hi(in.v.x); x[3] = bf_lo(in.v.y); x[4] = bf_hi(in.v.y); x[5] = bf_lo(in.v.z); x[6] = bf_hi(in.v.z); x[7] = bf_lo(in.v.w); x[8] = bf_hi(in.v.w);
#pragma unroll
    for (int i = 0; i < 8; ++i) o[i] = w0 * x[i] + w1 * x[i + 1] + w2 * x[i + 2] + bias;
}
__device__ __forceinline__ void conv8(const bf16_t* __restrict__ row, int b, int s0, float w0, float w1, float w2, float bias, float (&o)[8]) {
    const Conv8In in = conv8_load(row, b, s0); conv8_apply(in, w0, w1, w2, bias, o);
}

__device__ __forceinline__ void hyena_item(const Params& p, LAS unsigned char* lds, int l, int c) {
    const int tid = otid();
    LAS c2* X = (LAS c2*)lds;
    const c2* tw = (const c2*)(p.ws + WS_TW);
    const bf16_t* HY = (const bf16_t*)(p.ws + WS_VHT) + (size_t)512 * T;
    const bf16_t* r_x0 = HY + (size_t)c * T; const bf16_t* r_x1 = HY + (size_t)(512 + c) * T; const bf16_t* r_vv = HY + (size_t)(1024 + c) * T;
    const float* cw = p.in[7] + (size_t)l * 3 * 1536; const float* cb = p.in[8] + (size_t)l * 1536;
    const float x0w0 = cw[c], x0w1 = cw[1536 + c], x0w2 = cw[3072 + c], x0b = cb[c];
    const float x1w0 = cw[512 + c], x1w1 = cw[1536 + 512 + c], x1w2 = cw[3072 + 512 + c], x1b = cb[512 + c];
    const float vw0 = cw[1024 + c], vw1 = cw[1536 + 1024 + c], vw2 = cw[3072 + 1024 + c], vb = cb[1024 + c];
    LAS c2* TWL = (LAS c2*)(lds + 131072 + 1024);
    if (tid < 256) TWL[tid] = tw[tid < 128 ? tid * 128 : tid - 128];
#pragma unroll
    for (int it = 0; it < 2; ++it) {
        const int s0 = (tid + 512 * it) * 8;
        float a0[8], a1[8], v0[8], v1[8];
        conv8(r_x1, 0, s0, x1w0, x1w1, x1w2, x1b, a0); conv8(r_x1, 1, s0, x1w0, x1w1, x1w2, x1b, a1);
        conv8(r_vv, 0, s0, vw0, vw1, vw2, vb, v0); conv8(r_vv, 1, s0, vw0, vw1, vw2, vb, v1);
#pragma unroll
        for (int i = 0; i < 8; ++i) X[sw(s0 + i)] = mk2(a0[i] * v0[i], a1[i] * v1[i]);
    }
    __syncthreads();
    const c2* HF = (const c2*)(p.ws + WS_HF) + (size_t)c * NFFT;
    c2 hfr[32];
#pragma unroll
    for (int i = 0; i < 8; ++i) { const f32x4 h01 = *(const f32x4*)(HF + 4 * (tid + 512 * i)), h23 = *(const f32x4*)(HF + 4 * (tid + 512 * i) + 2);
        hfr[4 * i + 0] = mk2(h01[0], h01[1]); hfr[4 * i + 1] = mk2(h01[2], h01[3]); hfr[4 * i + 2] = mk2(h23[0], h23[1]); hfr[4 * i + 3] = mk2(h23[2], h23[3]); }
    fft_fwd<true, true>(X, TWL);
#pragma unroll
    for (int i = 0; i < 8; ++i) {
        const int b4 = 4 * (tid + 512 * i);
        const int i0 = sw(b4), i1 = sw(b4 + 1), i2 = sw(b4 + 2), i3 = sw(b4 + 3);
        const c2 a0 = X[i0], a1 = X[i1], a2 = X[i2], a3 = X[i3];
        c2 b0 = cadd(a0, a2), b1 = csub(a0, a2), b2 = cadd(a1, a3), d = csub(a1, a3);
        c2 b3 = mk2(d.y, -d.x);
        const c2 y0 = cmul(cadd(b0, b2), hfr[4 * i + 0]), y1 = cmul(cadd(b1, b3), hfr[4 * i + 1]), y2 = cmul(csub(b0, b2), hfr[4 * i + 2]), y3 = cmul(csub(b1, b3), hfr[4 * i + 3]);
        b0 = cadd(y0, y2); b1 = csub(y0, y2); b2 = cadd(y1, y3); d = csub(y1, y3);
        b3 = mk2(-d.y, d.x);
        X[i0] = cadd(b0, b2); X[i1] = cadd(b1, b3); X[i2] = csub(b0, b2); X[i3] = csub(b1, b3);
    }
    __syncthreads();
    Conv8In xin[2][2];
#pragma unroll
    for (int it = 0; it < 2; ++it) { xin[it][0] = conv8_load(r_x0, 0, (tid + 512 * it) * 8); xin[it][1] = conv8_load(r_x0, 1, (tid + 512 * it) * 8); }
    fft_inv<true, true>(X, TWL);
    bf16_t* BT = (bf16_t*)(p.ws + WS_BOUTT) + (size_t)c * T;
#pragma unroll
    for (int it = 0; it < 2; ++it) {
        const int s0 = (tid + 512 * it) * 8;
        float g0[8], g1[8];
        conv8_apply(xin[it][0], x0w0, x0w1, x0w2, x0b, g0); conv8_apply(xin[it][1], x0w0, x0w1, x0w2, x0b, g1);
        float y0[8], y1[8];
#pragma unroll
        for (int i = 0; i < 8; ++i) { const c2 y = X[sw(s0 + i)]; y0[i] = y.x * g0[i]; y1[i] = y.y * g1[i]; }
        u32x4 w0, w1;
        w0.x = cvt_pk_bf16(y0[0], y0[1]); w0.y = cvt_pk_bf16(y0[2], y0[3]); w0.z = cvt_pk_bf16(y0[4], y0[5]); w0.w = cvt_pk_bf16(y0[6], y0[7]);
        w1.x = cvt_pk_bf16(y1[0], y1[1]); w1.y = cvt_pk_bf16(y1[2], y1[3]); w1.z = cvt_pk_bf16(y1[4], y1[5]); w1.w = cvt_pk_bf16(y1[6], y1[7]);
        __builtin_nontemporal_store(w0, (u32x4*)(BT + s0)); __builtin_nontemporal_store(w1, (u32x4*)(BT + SEQ + s0));
    }
    __syncthreads();
}

__device__ __forceinline__ void bout_panel_transpose(const Params& p, LAS unsigned char* lds, int pm) {
    const int tid = otid(), lane = tid & 63, wv = tid >> 6;
    const bf16_t* BT = (const bf16_t*)(p.ws + WS_BOUTT);
    bf16_t* BO = (bf16_t*)(p.ws + WS_BOUT);
    LAS unsigned short* tile = (LAS unsigned short*)(lds + wv * 8704);
    for (int tl = wv; tl < 32; tl += 8) {
        const int t0 = pm * 256 + (tl & 3) * 64, c0 = (tl >> 2) * 64;
        const bf16_t* src = BT + (size_t)(c0 + lane) * T + t0;
        u32x4 v[8];
#pragma unroll
        for (int k = 0; k < 8; ++k) v[k] = *(const u32x4*)(src + k * 8);
#pragma unroll
        for (int k = 0; k < 8; ++k)
#pragma unroll
            for (int j = 0; j < 4; ++j) *(LAS unsigned*)(tile + lane * 66 + k * 8 + 2 * j) = v[k][j];
        __builtin_amdgcn_wave_barrier();
        bf16_t* dst = BO + (size_t)(t0 + lane) * 512 + c0;
#pragma unroll
        for (int c8 = 0; c8 < 8; ++c8) {
            u32x4 w;
#pragma unroll
            for (int j = 0; j < 4; ++j) { const unsigned lo = tile[(c8 * 8 + 2 * j) * 66 + lane], hi = tile[(c8 * 8 + 2 * j + 1) * 66 + lane]; w[j] = lo | (hi << 16); }
            *(u32x4*)(dst + c8 * 8) = w;
        }
        __builtin_amdgcn_wave_barrier();
    }
}

__device__ __forceinline__ void norm_frag(const u32x4 r0, const u32x4 r1, const float (&gw)[16], bf16x8& f0, bf16x8& f1) {
    float v[16];
    v[0] = bf_lo(r0.x); v[1] = bf_hi(r0.x); v[2] = bf_lo(r0.y); v[3] = bf_hi(r0.y); v[4] = bf_lo(r0.z); v[5] = bf_hi(r0.z); v[6] = bf_lo(r0.w); v[7] = bf_hi(r0.w);
    v[8] = bf_lo(r1.x); v[9] = bf_hi(r1.x); v[10] = bf_lo(r1.y); v[11] = bf_hi(r1.y); v[12] = bf_lo(r1.z); v[13] = bf_hi(r1.z); v[14] = bf_lo(r1.w); v[15] = bf_hi(r1.w);
    float ss = 0.f;
#pragma unroll
    for (int i = 0; i < 16; ++i) ss += v[i] * v[i];
    ss += __shfl_xor(ss, 16); ss += __shfl_xor(ss, 32);
    const float rs = rsqrtf(ss * (1.f / 64.f) + 1e-6f);
#pragma unroll
    for (int i = 0; i < 16; ++i) v[i] *= rs * gw[i];
    u32x4 a, b;
    a.x = cvt_pk_bf16(v[0], v[1]); a.y = cvt_pk_bf16(v[2], v[3]); a.z = cvt_pk_bf16(v[4], v[5]); a.w = cvt_pk_bf16(v[6], v[7]);
    b.x = cvt_pk_bf16(v[8], v[9]); b.y = cvt_pk_bf16(v[10], v[11]); b.z = cvt_pk_bf16(v[12], v[13]); b.w = cvt_pk_bf16(v[14], v[15]);
    f0 = __builtin_bit_cast(bf16x8, a); f1 = __builtin_bit_cast(bf16x8, b);
}

__device__ __forceinline__ void na_task(const Params& p, LAS float* rpb_l, int l, int task) {
    const int lane = otid() & 63, n = lane & 15, g = lane >> 4;
    const int h = task & 7, r = (task >> 3) & 127, b = task >> 10;
    int r0 = r - 4; r0 = r0 < 0 ? 0 : (r0 > 120 ? 120 : r0);
    const float* rp = p.in[6] + (size_t)(l * 8 + h) * 465;
    for (int i = lane; i < 465; i += 64) rpb_l[i] = rp[i];
    float gq[16];
#pragma unroll
    for (int ks = 0; ks < 2; ++ks)
#pragma unroll
        for (int e = 0; e < 8; ++e) gq[ks * 8 + e] = p.in[4][l * 64 + ks * 32 + g * 8 + e] * p.in[5][l * 64 + ks * 32 + g * 8 + e] * 0.125f;
    const bf16_t* QK = (const bf16_t*)(p.ws + WS_QK);
    const bf16_t* VT = (const bf16_t*)(p.ws + WS_VHT);
    bf16_t* AO = (bf16_t*)(p.ws + WS_AOUT);
    const size_t tokrow = (size_t)b * SEQ + (size_t)r * 64;
    __builtin_amdgcn_wave_barrier();
#pragma unroll 1
    for (int qt = 0; qt < 4; ++qt) {
        bf16x8 qf0, qf1;
        { const bf16_t* qp = QK + (tokrow + qt * 16 + n) * 1024 + h * 64 + g * 8;
          norm_frag(*(const u32x4*)qp, *(const u32x4*)(qp + 32), gq, qf0, qf1); }
        const int kc0 = (qt == 0) ? 0 : (qt == 1 ? 8 : (qt == 2 ? 24 : 32));
        f32x4 st[8][2];
#pragma unroll
        for (int jh = 0; jh < 2; ++jh) {
            u32x4 kr[4][2][2];
#pragma unroll
            for (int jj = 0; jj < 4; ++jj)
#pragma unroll
                for (int ct = 0; ct < 2; ++ct) {
                    const bf16_t* kp = QK + ((size_t)b * SEQ + (size_t)(r0 + jh * 4 + jj) * 64 + kc0 + ct * 16 + n) * 1024 + 512 + h * 64 + g * 8;
                    kr[jj][ct][0] = *(const u32x4*)kp; kr[jj][ct][1] = *(const u32x4*)(kp + 32);
                }
            __builtin_amdgcn_sched_barrier(0);
#pragma unroll
            for (int jj = 0; jj < 4; ++jj)
#pragma unroll
                for (int ct = 0; ct < 2; ++ct) {
                    const bf16x8 kf0 = __builtin_bit_cast(bf16x8, kr[jj][ct][0]), kf1 = __builtin_bit_cast(bf16x8, kr[jj][ct][1]);
                    f32x4 a = (f32x4){0.f, 0.f, 0.f, 0.f}, d = (f32x4){0.f, 0.f, 0.f, 0.f};
                    a = __builtin_amdgcn_mfma_f32_16x16x32_bf16(kf0, qf0, a, 0, 0, 0);
                    a = __builtin_amdgcn_mfma_f32_16x16x32_bf16(kf1, qf1, a, 0, 0, 0);
                    d = __builtin_amdgcn_mfma_f32_16x16x32_bf16(kf0, kf0, d, 0, 0, 0);
                    d = __builtin_amdgcn_mfma_f32_16x16x32_bf16(kf1, kf1, d, 0, 0, 0);
                    const int n3 = n & 3;
                    const float dsel = (n3 == 0) ? d[0] : (n3 == 1 ? d[1] : (n3 == 2 ? d[2] : d[3]));
                    const float rkl = rsqrtf(dsel * (1.f / 64.f) + 1e-6f);
                    f32x4 rk4;
#pragma unroll
                    for (int i = 0; i < 4; ++i) rk4[i] = __shfl(rkl, 20 * g + i);
                    st[jh * 4 + jj][ct] = a * rk4;
                }
        }
        const int cq = qt * 16 + n; int c0 = cq - 8; c0 = c0 < 0 ? 0 : (c0 > 48 ? 48 : c0);
        float mx = -INFINITY;
#pragma unroll
        for (int j = 0; j < 8; ++j) { const int dr = r0 + j - r + 7;
#pragma unroll
            for (int ct = 0; ct < 2; ++ct)
#pragma unroll
                for (int i = 0; i < 4; ++i) { const int ck = kc0 + ct * 16 + g * 4 + i; const bool valid = (ck >= c0) && (ck < c0 + 16);
                    int dc = ck - cq + 15; dc = dc < 0 ? 0 : (dc > 30 ? 30 : dc);
                    float v = st[j][ct][i] + rpb_l[dr * 31 + dc]; v = valid ? v : -INFINITY; st[j][ct][i] = v; mx = fmaxf(mx, v); } }
        mx = fmaxf(mx, __shfl_xor(mx, 16)); mx = fmaxf(mx, __shfl_xor(mx, 32));
        float sum = 0.f;
#pragma unroll
        for (int j = 0; j < 8; ++j)
#pragma unroll
            for (int ct = 0; ct < 2; ++ct)
#pragma unroll
                for (int i = 0; i < 4; ++i) { const float e = __expf(st[j][ct][i] - mx); st[j][ct][i] = e; sum += e; }
        sum += __shfl_xor(sum, 16); sum += __shfl_xor(sum, 32);
        f32x4 o[4];
#pragma unroll
        for (int nd = 0; nd < 4; ++nd) o[nd] = (f32x4){0.f, 0.f, 0.f, 0.f};
#pragma unroll
        for (int jp = 0; jp < 4; ++jp) {
            u32x2 vr[2][4][2];
#pragma unroll
            for (int jj = 0; jj < 2; ++jj) {
                const size_t tk0 = (size_t)b * SEQ + (size_t)(r0 + jp * 2 + jj) * 64 + kc0 + g * 4;
#pragma unroll
                for (int nd = 0; nd < 4; ++nd) { const bf16_t* vp = VT + (size_t)(h * 64 + nd * 16 + n) * T + tk0; vr[jj][nd][0] = *(const u32x2*)vp; vr[jj][nd][1] = *(const u32x2*)(vp + 16); }
            }
            __builtin_amdgcn_sched_barrier(0);
#pragma unroll
            for (int jj = 0; jj < 2; ++jj) {
                const int j = jp * 2 + jj;
                u32x4 pw; pw.x = cvt_pk_bf16(st[j][0][0], st[j][0][1]); pw.y = cvt_pk_bf16(st[j][0][2], st[j][0][3]); pw.z = cvt_pk_bf16(st[j][1][0], st[j][1][1]); pw.w = cvt_pk_bf16(st[j][1][2], st[j][1][3]);
                const bf16x8 pf = __builtin_bit_cast(bf16x8, pw);
#pragma unroll
                for (int nd = 0; nd < 4; ++nd) {
                    u32x4 vw; vw.x = vr[jj][nd][0].x; vw.y = vr[jj][nd][0].y; vw.z = vr[jj][nd][1].x; vw.w = vr[jj][nd][1].y;
                    o[nd] = __builtin_amdgcn_mfma_f32_16x16x32_bf16(__builtin_bit_cast(bf16x8, vw), pf, o[nd], 0, 0, 0);
                }
            }
        }
        const float inv = 1.f / sum;
#pragma unroll
        for (int nd = 0; nd < 4; ++nd) { u32x2 w; w.x = cvt_pk_bf16(o[nd][0] * inv, o[nd][1] * inv); w.y = cvt_pk_bf16(o[nd][2] * inv, o[nd][3] * inv);
            *(u32x2*)(AO + (tokrow + qt * 16 + n) * 512 + h * 64 + nd * 16 + g * 4) = w; }
    }
}

__device__ __forceinline__ void cas_desc(unsigned& a, unsigned& b) { const unsigned mx = a > b ? a : b, mn = a > b ? b : a; a = mx; b = mn; }
__device__ __forceinline__ void sort16_desc(unsigned (&v)[16]) {
#pragma unroll
    for (int k = 2; k <= 16; k <<= 1)
#pragma unroll
        for (int j = k >> 1; j > 0; j >>= 1)
#pragma unroll
            for (int i = 0; i < 16; ++i) { const int l = i ^ j; if (l > i) { if ((i & k) == 0) cas_desc(v[i], v[l]); else cas_desc(v[l], v[i]); } }
}
__device__ __forceinline__ void merge16_desc(unsigned (&v)[16]) {
#pragma unroll
    for (int j = 8; j > 0; j >>= 1)
#pragma unroll
        for (int i = 0; i < 16; ++i) { const int l = i ^ j; if (l > i) cas_desc(v[i], v[l]); }
}

__device__ __forceinline__ void topk_task(const Params& p, LAS float* sc, int l, int task) {
    const int lane = otid() & 63, n = lane & 15, g = lane >> 4;
    const int list = task & 15, tokblk = task >> 4;
    const bf16_t* QP = (const bf16_t*)(p.ws + WS_QPEER);
    const bf16_t* SK = (const bf16_t*)(p.ws + WS_SK) + ((size_t)l * 16 + list) * 128 * 128;
    bf16x8 qf[2][4];
#pragma unroll
    for (int tt = 0; tt < 2; ++tt)
#pragma unroll
        for (int ks = 0; ks < 4; ++ks) qf[tt][ks] = *(const bf16x8*)(QP + (size_t)(tokblk * 32 + tt * 16 + n) * 2048 + list * 128 + ks * 32 + g * 8);
#pragma unroll 2
    for (int kt = 0; kt < 8; ++kt) {
        bf16x8 kf[4];
#pragma unroll
        for (int ks = 0; ks < 4; ++ks) kf[ks] = *(const bf16x8*)(SK + (size_t)(kt * 16 + n) * 128 + ks * 32 + g * 8);
#pragma unroll
        for (int tt = 0; tt < 2; ++tt) {
            f32x4 a = (f32x4){0.f, 0.f, 0.f, 0.f};
#pragma unroll
            for (int ks = 0; ks < 4; ++ks) a = __builtin_amdgcn_mfma_f32_16x16x32_bf16(kf[ks], qf[tt][ks], a, 0, 0, 0);
            *(LAS f32x4*)(sc + (tt * 16 + n) * 136 + kt * 16 + g * 4) = a;
        }
    }
    __builtin_amdgcn_wave_barrier();
    const int row = lane >> 1, half = lane & 1;
    unsigned best[16];
#pragma unroll
    for (int grp = 0; grp < 4; ++grp) {
        unsigned v[16];
#pragma unroll
        for (int i = 0; i < 4; ++i) { const int chunk = 2 * (grp * 4 + i) + half;
            const f32x4 s4 = *(const LAS f32x4*)(sc + row * 136 + chunk * 4);
#pragma unroll
            for (int e = 0; e < 4; ++e) v[i * 4 + e] = (fmap(s4[e]) & ~0x7Fu) | (unsigned)(127 - (chunk * 4 + e)); }
        sort16_desc(v);
        if (grp == 0) {
#pragma unroll
            for (int i = 0; i < 16; ++i) best[i] = v[i];
        } else {
#pragma unroll
            for (int i = 0; i < 16; ++i) best[i] = best[i] > v[15 - i] ? best[i] : v[15 - i];
            merge16_desc(best);
        }
    }
    {
        unsigned oth[16];
#pragma unroll
        for (int i = 0; i < 16; ++i) oth[i] = (unsigned)__shfl_xor((int)best[i], 1);
#pragma unroll
        for (int i = 0; i < 16; ++i) best[i] = best[i] > oth[15 - i] ? best[i] : oth[15 - i];
        merge16_desc(best);
    }
    __builtin_amdgcn_wave_barrier();
    unsigned* TK = (unsigned*)(p.ws + WS_TOPK) + ((size_t)(tokblk * 32 + row) * 16 + list) * 16 + half * 8;
    u32x4 w0, w1;
    if (half == 0) { w0.x = best[0]; w0.y = best[1]; w0.z = best[2]; w0.w = best[3]; w1.x = best[4]; w1.y = best[5]; w1.z = best[6]; w1.w = best[7]; }
    else { w0.x = best[8]; w0.y = best[9]; w0.z = best[10]; w0.w = best[11]; w1.x = best[12]; w1.y = best[13]; w1.z = best[14]; w1.w = best[15]; }
    *(u32x4*)TK = w0; *(u32x4*)(TK + 4) = w1;
}

__device__ __forceinline__ float gelu_tanh(float x) { const float u = 0.7978845608028654f * (x + 0.044715f * x * x * x); return 0.5f * x * (1.f + tanhf(u)); }

__device__ __forceinline__ void peer_token(const Params& p, LAS unsigned char* xh, int l, int tok, const unsigned char* cand_tab) {
    const int lane = otid() & 63, n = lane & 15, g = lane >> 4;
    const float* XM = (const float*)(p.ws + WS_XMID) + (size_t)tok * 1024;
    const float* g2 = p.in[19] + l * 1024;
    const unsigned* TK = (const unsigned*)(p.ws + WS_TOPK) + (size_t)tok * 256;
    const int ci = cand_tab[lane] >> 4, cj = cand_tab[lane] & 15;
    LAS unsigned* tkl = (LAS unsigned*)(xh + 1024);
    *(LAS u32x4*)(tkl + lane * 4) = *(const u32x4*)(TK + lane * 4);
    float xm[16];
#pragma unroll
    for (int i = 0; i < 4; ++i) { const f32x4 a = *(const f32x4*)(XM + lane * 16 + i * 4); xm[i * 4 + 0] = a[0]; xm[i * 4 + 1] = a[1]; xm[i * 4 + 2] = a[2]; xm[i * 4 + 3] = a[3]; }
    float ss = 0.f;
#pragma unroll
    for (int i = 0; i < 16; ++i) ss += xm[i] * xm[i];
    ss = wave_sum(ss);
    const float rstd = rsqrtf(ss * (1.f / 1024.f) + 1e-6f);
    {
        float xs[16];
#pragma unroll
        for (int i = 0; i < 4; ++i) { const f32x4 ga = *(const f32x4*)(g2 + lane * 16 + i * 4);
            const float r2 = 2.f * rstd; xs[i * 4 + 0] = xm[i * 4 + 0] * r2 * ga[0]; xs[i * 4 + 1] = xm[i * 4 + 1] * r2 * ga[1]; xs[i * 4 + 2] = xm[i * 4 + 2] * r2 * ga[2]; xs[i * 4 + 3] = xm[i * 4 + 3] * r2 * ga[3]; }
        u32x2 w; w.x = pack8_fp4(xs[0], xs[1], xs[2], xs[3], xs[4], xs[5], xs[6], xs[7]); w.y = pack8_fp4(xs[8], xs[9], xs[10], xs[11], xs[12], xs[13], xs[14], xs[15]);
        *(LAS u32x2*)(xh + lane * 8) = w;
    }
    __builtin_amdgcn_wave_barrier();
    float out[16];
#pragma unroll
    for (int i = 0; i < 16; ++i) out[i] = 0.f;
    const unsigned char* UT = p.ws + WS_UT + (size_t)l * 16384 * 512;
    const unsigned char* VT = p.ws + WS_VT + (size_t)l * 16384 * 512;
    const bool cvalid = lane < 50;
#pragma unroll 1
    for (int h = 0; h < 8; ++h) {
        const unsigned ka = tkl[32 * h + ci], kb = tkl[32 * h + 16 + cj];
        const float cand = funmap(ka & ~0x7Fu) + funmap(kb & ~0x7Fu);
        const int eid_src = (127 - (int)(ka & 0x7Fu)) * 128 + (127 - (int)(kb & 0x7Fu));
        unsigned ck = cvalid ? ((fmap(cand) & ~0xFFu) | (unsigned)lane) : 0u;
        int rank = 0;
#pragma unroll
        for (int m = 0; m < 50; ++m) rank += ((unsigned)__builtin_amdgcn_readlane((int)ck, m) > ck) ? 1 : 0;
        const int eid = __builtin_amdgcn_ds_permute(rank * 4, eid_src);
        const float fs = __int_as_float(__builtin_amdgcn_ds_permute(rank * 4, __float_as_int(cand))) * rstd;
        const float m0 = __int_as_float(__builtin_amdgcn_readlane(__float_as_int(fs), 0));
        const float ex = (lane < 16) ? __expf(fs - m0) : 0.f;
        const float gsm = ex / wave_sum(ex);
        const int eid_n = __shfl(eid, n);
        u32x4 uu[8]; u32x2 vv[16];
        const unsigned char* up = UT + (size_t)eid_n * 512 + g * 16;
#pragma unroll
        for (int i = 0; i < 8; ++i) uu[i] = *(const u32x4*)(up + i * 64);
#pragma unroll
        for (int k = 0; k < 16; ++k) { const int ek = __builtin_amdgcn_readlane(eid, k); vv[k] = *(const u32x2*)(VT + (size_t)ek * 512 + lane * 8); }
        f32x4 acc = (f32x4){0.f, 0.f, 0.f, 0.f};
        __builtin_amdgcn_sched_barrier(0);
#pragma unroll
        for (int i = 0; i < 8; ++i) {
            const u32x4 x0 = *(const LAS u32x4*)(xh + i * 64 + g * 16);
            v8i_t av, bv;
            av[0] = (int)x0.x; av[1] = (int)x0.y; av[2] = (int)x0.z; av[3] = (int)x0.w;
            bv[0] = (int)uu[i].x; bv[1] = (int)uu[i].y; bv[2] = (int)uu[i].z; bv[3] = (int)uu[i].w;
            acc = __builtin_amdgcn_mfma_scale_f32_16x16x128_f8f6f4(av, bv, acc, 4  , 4  , 0, 127, 0, 127);
            __builtin_amdgcn_sched_barrier(0);
        }
        const float wgt = gsm * gelu_tanh(acc[0] * (1.f / 128.f)) * (1.f / 64.f);
#pragma unroll
        for (int k = 0; k < 16; ++k) {
            const float wk = __int_as_float(__builtin_amdgcn_readlane(__float_as_int(wgt), k));
#ifdef DIAG_VF32
            { const int ek2 = __builtin_amdgcn_readfirstlane(__shfl(eid, k)); const float* vf = p.in[23] + ((size_t)l * 16384 + ek2) * 1024 + lane * 16;
#pragma unroll
              for (int j = 0; j < 16; ++j) out[j] += wk * 64.f * vf[j]; }
            if (false)
#endif
#pragma unroll
            for (int q = 0; q < 2; ++q)
            {
                const f32x2 f0 = __builtin_amdgcn_cvt_scalef32_pk_f32_fp4(vv[k][q], 1.0f, 0), f1 = __builtin_amdgcn_cvt_scalef32_pk_f32_fp4(vv[k][q], 1.0f, 1);
                const f32x2 f2 = __builtin_amdgcn_cvt_scalef32_pk_f32_fp4(vv[k][q], 1.0f, 2), f3 = __builtin_amdgcn_cvt_scalef32_pk_f32_fp4(vv[k][q], 1.0f, 3);
                out[q * 8 + 0] += wk * f0.x; out[q * 8 + 1] += wk * f0.y; out[q * 8 + 2] += wk * f1.x; out[q * 8 + 3] += wk * f1.y;
                out[q * 8 + 4] += wk * f2.x; out[q * 8 + 5] += wk * f2.y; out[q * 8 + 6] += wk * f3.x; out[q * 8 + 7] += wk * f3.y;
            }
        }
    }
    float ss2 = 0.f;
#pragma unroll
    for (int i = 0; i < 16; ++i) { out[i] += xm[i]; ss2 += out[i] * out[i]; }
    float* XO = p.out + (size_t)tok * 1024 + lane * 16;
#pragma unroll
    for (int i = 0; i < 4; ++i) *(f32x4*)(XO + i * 4) = (f32x4){out[i * 4 + 0], out[i * 4 + 1], out[i * 4 + 2], out[i * 4 + 3]};
    if (l < DEPTH - 1) {
        ss2 = wave_sum(ss2);
        const float rs = rsqrtf(ss2 * (1.f / 1024.f) + 1e-6f);
        bf16_t* xb = (bf16_t*)(p.ws + WS_XB) + (size_t)tok * 1024 + lane * 16;
#pragma unroll
        for (int i = 0; i < 2; ++i) { u32x4 w; w.x = cvt_pk_bf16(out[i * 8 + 0] * rs, out[i * 8 + 1] * rs); w.y = cvt_pk_bf16(out[i * 8 + 2] * rs, out[i * 8 + 3] * rs);
            w.z = cvt_pk_bf16(out[i * 8 + 4] * rs, out[i * 8 + 5] * rs); w.w = cvt_pk_bf16(out[i * 8 + 6] * rs, out[i * 8 + 7] * rs);
            *(u32x4*)(xb + i * 8) = w; }
    }
    __builtin_amdgcn_wave_barrier();
}

#ifdef DIAG
constexpr size_t WS_DIAG = WS_END;
__device__ __forceinline__ unsigned hsh(unsigned a) { a ^= a >> 16; a *= 0x7feb352du; a ^= a >> 15; a *= 0x846ca68bu; a ^= a >> 16; return a; }
__device__ __forceinline__ float bfr(float f) { return bf_lo(cvt_pk_bf16(f, 0.f) & 0xffffu); }
__device__ __forceinline__ void report(float* dg, int k, float a, float e, float fl) { const float r = fabsf(a - e) / (fabsf(e) + fl); atomicMax((unsigned*)dg + k, __float_as_uint(r != r ? 1e30f : r)); }
__device__ __forceinline__ float conv1(const bf16_t* row, int b, int s, float w0, float w1, float w2, float bias) {
    const bf16_t* rp = row + (size_t)b * SEQ;
    const float xm = s > 0 ? bf1(rp[s - 1]) : 0.f, x0 = bf1(rp[s]), xp = s < SEQ - 1 ? bf1(rp[s + 1]) : 0.f;
    return w0 * xm + w1 * x0 + w2 * xp + bias;
}
__device__ __forceinline__ void diag_checks(const Params& p) {
    const int tid = otid(); unsigned char* ws = p.ws; float* dg = (float*)(ws + WS_DIAG);
    const int chk = blockIdx.x; const int l = 0;
    const bf16_t* XB = (const bf16_t*)(ws + WS_XB);
    if (chk == 0 && tid < 256) {
        const unsigned hh = hsh(tid * 7 + 1); const int n = hh % 3072, k = (hh >> 12) % 1024; const int sc = n < 1024 ? n : n + 2048;
        report(dg, 0, bf1(((const bf16_t*)(ws + WS_WTA))[(size_t)n * 1024 + k]), bfr(p.in[2][(size_t)k * 5120 + sc] * p.in[1][k]), 1e-3f);
        const int n2 = hh % 2048; report(dg, 0, bf1(((const bf16_t*)(ws + WS_WQ))[(size_t)n2 * 1024 + k]), bfr(p.in[20][(size_t)k * 2048 + n2] * p.in[19][k]), 1e-3f);
        const int n3 = hh % 1024, k3 = (hh >> 12) % 512; report(dg, 0, bf1(((const bf16_t*)(ws + WS_WHY))[(size_t)n3 * 512 + k3]), bfr(p.in[17][(size_t)k3 * 1024 + n3]), 1e-3f);
        const int n4 = hh % 2048; const int sc4 = n4 + 1024; report(dg, 0, bf1(((const bf16_t*)(ws + WS_WTB))[(size_t)n4 * 1024 + k]), bfr(p.in[2][(size_t)k * 5120 + sc4] * p.in[1][k]), 1e-3f);
    }
    if (chk == 3 && tid < 256) {
        const unsigned hh = hsh(tid * 13 + 5); const int tok = hh % T, h = (hh >> 16) % 8, d = (hh >> 20) % 64;
        const bf16_t* QK = (const bf16_t*)(ws + WS_QK); const bf16_t* VT = (const bf16_t*)(ws + WS_VHT);
        const int b = tok / SEQ, s = tok % SEQ, r = s / 64, cq = s % 64;
        int r0 = r - 4; r0 = r0 < 0 ? 0 : (r0 > 120 ? 120 : r0); int c0 = cq - 8; c0 = c0 < 0 ? 0 : (c0 > 48 ? 48 : c0);
        float sq = 0.f; for (int i = 0; i < 64; ++i) { const float v = bf1(QK[(size_t)tok * 1024 + h * 64 + i]); sq += v * v; }
        const float rq = rsqrtf(sq / 64.f + 1e-6f);
        float mx = -INFINITY, sum = 0.f, o = 0.f;
        for (int pass = 0; pass < 2; ++pass)
            for (int j = 0; j < 8; ++j) for (int cc = 0; cc < 16; ++cc) {
                const int kt = b * SEQ + (r0 + j) * 64 + c0 + cc; float sk = 0.f, dot = 0.f;
                for (int i = 0; i < 64; ++i) { const float kv = bf1(QK[(size_t)kt * 1024 + 512 + h * 64 + i]); sk += kv * kv; dot += kv * p.in[5][l * 64 + i] * bf1(QK[(size_t)tok * 1024 + h * 64 + i]) * p.in[4][l * 64 + i]; }
                int dc = (c0 + cc) - cq + 15; dc = dc < 0 ? 0 : (dc > 30 ? 30 : dc);
                const float sc = dot * rq * rsqrtf(sk / 64.f + 1e-6f) * 0.125f + p.in[6][(size_t)((l * 8 + h) * 15 + (r0 + j - r + 7)) * 31 + dc];
                if (pass == 0) mx = fmaxf(mx, sc); else { const float e = expf(sc - mx); sum += e; o += e * bf1(VT[(size_t)(h * 64 + d) * T + kt]); }
            }
        report(dg, 3, bf1(((const bf16_t*)(ws + WS_AOUT))[(size_t)tok * 512 + h * 64 + d]), o / sum, 0.02f);
    }
    if (chk == 4 && tid < 64) {
        const unsigned hh = hsh(tid * 17 + 3); const int b = hh & 1, t = (hh >> 1) % SEQ, c = (hh >> 16) % 512;
        const bf16_t* HY = (const bf16_t*)(ws + WS_VHT) + (size_t)512 * T;
        const float* cw = p.in[7] + (size_t)l * 3 * 1536; const float* cb = p.in[8] + (size_t)l * 1536;
        const float* H2 = (const float*)(ws + WS_H2) + (size_t)l * SEQ * 64; const float* w3 = p.in[14] + (size_t)l * 64 * 1024;
        const float ad = fabsf(-3.0701134573253945f + (-15.350567286626972f + 3.0701134573253945f) * ((float)c / 511.f));
        float y = 0.f;
        for (int s = 0; s < SEQ; ++s) {
            const float z = conv1(HY + (size_t)(1024 + c) * T, b, s, cw[1024 + c], cw[1536 + 1024 + c], cw[3072 + 1024 + c], cb[1024 + c]) * conv1(HY + (size_t)(512 + c) * T, b, s, cw[512 + c], cw[1536 + 512 + c], cw[3072 + 512 + c], cb[512 + c]);
            const int dlt = t - s, ad_ = dlt < 0 ? -dlt : dlt; float hv = 0.f;
            const float dec = expf(-(float)ad_ * (1.f / 8191.f) * ad);
            if (dlt >= 0) { float a = 0.f; for (int j = 0; j < 64; ++j) a += H2[(size_t)ad_ * 64 + j] * w3[j * 1024 + c]; hv += a * dec; }
            if (dlt <= 0) { float a = 0.f; for (int j = 0; j < 64; ++j) a += H2[(size_t)ad_ * 64 + j] * w3[j * 1024 + 512 + c]; hv += a * dec; }
            if (dlt == 0) hv += p.in[15][l * 512 + c];
            y += z * hv;
        }
        y *= conv1(HY + (size_t)c * T, b, t, cw[c], cw[1536 + c], cw[3072 + c], cb[c]);
        report(dg, 4, bf1(((const bf16_t*)(ws + WS_BOUT))[(size_t)(b * SEQ + t) * 512 + c]), y, 0.05f);
    }
    if (chk == 5 && tid < 256) {
        const unsigned hh = hsh(tid * 19 + 7); const int row = hh % T, col = (hh >> 16) % 1024;
        float d0 = 0.f, d1 = 0.f;
        for (int k = 0; k < 512; ++k) { d0 += bf1(((const bf16_t*)(ws + WS_AOUT))[(size_t)row * 512 + k]) * bf1(((const bf16_t*)(ws + WS_WNA))[(size_t)col * 512 + k]);
            d1 += bf1(((const bf16_t*)(ws + WS_BOUT))[(size_t)row * 512 + k]) * bf1(((const bf16_t*)(ws + WS_WHY))[(size_t)col * 512 + k]); }
        const bf16_t* GT = (const bf16_t*)(ws + WS_GATE);
        report(dg, 5, bf1(((const bf16_t*)(ws + WS_MERGED))[(size_t)row * 1024 + col]), bf1(GT[(size_t)row * 2048 + col]) * d0 + bf1(GT[(size_t)row * 2048 + 1024 + col]) * d1, 0.02f);
    }
    if (chk == 6 && tid < 256) {
        const unsigned hh = hsh(tid * 23 + 9); const int row = hh % T, col = (hh >> 16) % 1024;
        float d0 = 0.f; for (int k = 0; k < 1024; ++k) d0 += bf1(((const bf16_t*)(ws + WS_MERGED))[(size_t)row * 1024 + k]) * bf1(((const bf16_t*)(ws + WS_WOUT))[(size_t)col * 1024 + k]);
        report(dg, 6, ((const float*)(ws + WS_XMID))[(size_t)row * 1024 + col], p.in[0][(size_t)row * 1024 + col] + d0, 0.02f);
        report(dg, 6, bf1(((const bf16_t*)(ws + WS_XBMID))[(size_t)row * 1024 + col]), p.in[0][(size_t)row * 1024 + col] + d0, 0.02f);
    }
    if (chk == 7 && tid < 256) {
        const unsigned hh = hsh(tid * 29 + 11); const int row = hh % T, col = (hh >> 16) % 2048;
        float d0 = 0.f; for (int k = 0; k < 1024; ++k) d0 += bf1(((const bf16_t*)(ws + WS_XBMID))[(size_t)row * 1024 + k]) * bf1(((const bf16_t*)(ws + WS_WQ))[(size_t)col * 1024 + k]);
        report(dg, 7, bf1(((const bf16_t*)(ws + WS_QPEER))[(size_t)row * 2048 + col]), d0, 0.05f);
    }
    if (chk == 8 && tid < 64) {
        const unsigned hh = hsh(tid * 31 + 13); const int tok = hh % T, list = (hh >> 16) % 16;
        const bf16_t* QP = (const bf16_t*)(ws + WS_QPEER) + (size_t)tok * 2048 + list * 128; const bf16_t* SK = (const bf16_t*)(ws + WS_SK) + (size_t)(l * 16 + list) * 128 * 128;
        const unsigned* TK = (const unsigned*)(ws + WS_TOPK) + ((size_t)tok * 16 + list) * 16;
        float pv = INFINITY; int pi = -1; int bad = 0;
        for (int r = 0; r < 16; ++r) {
            float bv = -INFINITY; int bi = -1;
            for (int key = 0; key < 128; ++key) { float sc = 0.f; for (int d = 0; d < 128; ++d) sc += bf1(QP[d]) * bf1(SK[key * 128 + d]);
                const bool lt = (sc < pv) || (sc == pv && key > pi); if (lt && sc > bv) { bv = sc; bi = key; } }
            const unsigned kk = TK[r]; const int gi = 127 - (int)(kk & 0x7Fu); const float gv = funmap(kk & ~0x7Fu);
            if (gi != bi) ++bad; report(dg, 9, gv, bv, 0.05f);
            pv = bv; pi = bi;
        }
        atomicMax((unsigned*)dg + 8, __float_as_uint((float)bad / 16.f));
    }
}
__device__ __forceinline__ void diag_peer(const Params& p) {
    const int tid = otid(); unsigned char* ws = p.ws; float* dg = (float*)(ws + WS_DIAG); const int l = 0;
    if (blockIdx.x != 10 || tid >= 64) return;
    const unsigned hh = hsh(tid * 37 + 17); const int tok = hh % T, d = (hh >> 16) % 1024;
    const float* XM = (const float*)(ws + WS_XMID) + (size_t)tok * 1024; const float* g2 = p.in[19] + l * 1024;
    float ss = 0.f; for (int k = 0; k < 1024; ++k) ss += XM[k] * XM[k];
    const float rstd = rsqrtf(ss / 1024.f + 1e-6f);
    const unsigned* TK = (const unsigned*)(ws + WS_TOPK) + (size_t)tok * 256;
    float outv = 0.f;
    for (int h = 0; h < 8; ++h) {
        float mx = -INFINITY, sum = 0.f, accv = 0.f;
        for (int pass = 0; pass < 2; ++pass) {
            float pv = INFINITY; int pi = -1;
            for (int r = 0; r < 16; ++r) {
                float bv = -INFINITY; int bi = -1;
                for (int c = 0; c < 256; ++c) { const float sc = funmap(TK[(2 * h) * 16 + (c >> 4)] & ~0x7Fu) + funmap(TK[(2 * h + 1) * 16 + (c & 15)] & ~0x7Fu);
                    const bool lt = (sc < pv) || (sc == pv && c > pi); if (lt && sc > bv) { bv = sc; bi = c; } }
                pv = bv; pi = bi;
                const float fs = bv * rstd;
                if (pass == 0) mx = fmaxf(mx, fs);
                else { const int eid = (127 - (int)(TK[(2 * h) * 16 + (bi >> 4)] & 0x7Fu)) * 128 + (127 - (int)(TK[(2 * h + 1) * 16 + (bi & 15)] & 0x7Fu));
                    const float e = expf(fs - mx); sum += e;
                    float dot = 0.f; for (int k = 0; k < 1024; ++k) dot += XM[k] * rstd * g2[k] * p.in[22][((size_t)l * 16384 + eid) * 1024 + k];
                    accv += e * gelu_tanh(dot) * p.in[23][((size_t)l * 16384 + eid) * 1024 + d]; }
            }
        }
        outv += accv / sum;
    }
    report(dg, 10, (p.out[(size_t)tok * 1024 + d] - XM[d]) * 0.2f, outv * 0.2f, 0.03f);
}
__device__ __forceinline__ void diag_inproj(const Params& p) {
    const int tid = otid(); unsigned char* ws = p.ws; float* dg = (float*)(ws + WS_DIAG); const int l = 0;
    const bf16_t* XB = (const bf16_t*)(ws + WS_XB);
    if (blockIdx.x == 1 && tid < 256) {
        const unsigned hh = hsh(tid * 41 + 19); const int row = hh % T, col = (hh >> 16) % 3072;
        float d0 = 0.f; for (int k = 0; k < 1024; ++k) d0 += bf1(XB[(size_t)row * 1024 + k]) * bf1(((const bf16_t*)(ws + WS_WTA))[(size_t)col * 1024 + k]);
        if (col < 1024) report(dg, 2, bf1(((const bf16_t*)(ws + WS_QK))[(size_t)row * 1024 + col]), d0, 0.02f);
        else report(dg, col < 2048 ? 1 : 11, bf1(((const bf16_t*)(ws + WS_GATE))[(size_t)row * 2048 + col - 1024]),
#ifdef DIAG_RAWGATE
 (d0 + p.in[3][l * 2048 + col - 1024])
#else
 1.f / (1.f + expf(-(d0 + p.in[3][l * 2048 + col - 1024])))
#endif
 , 0.02f);
    }
    if (blockIdx.x == 2 && tid < 256) {
        const unsigned hh = hsh(tid * 43 + 23); const int tok = hh % T, ch = (hh >> 16) % 2048;
        float d0 = 0.f; for (int k = 0; k < 1024; ++k) d0 += bf1(XB[(size_t)tok * 1024 + k]) * bf1(((const bf16_t*)(ws + WS_WTB))[(size_t)ch * 1024 + k]);
        report(dg, 2, bf1(((const bf16_t*)(ws + WS_VHT))[(size_t)ch * T + tok]), d0, 0.02f);
    }
    if (blockIdx.x == 11 && tid < 64) {
        const int tok = hsh(tid * 3 + 1) % T; float ss = 0.f; for (int k = 0; k < 1024; ++k) ss += p.in[0][(size_t)tok * 1024 + k] * p.in[0][(size_t)tok * 1024 + k];
        const int k = hsh(tid) % 1024; report(dg, 11, bf1(XB[(size_t)tok * 1024 + k]), p.in[0][(size_t)tok * 1024 + k] * rsqrtf(ss / 1024.f + 1e-6f), 1e-2f);
    }
}
__device__ __forceinline__ void diag_emit(const Params& p) {
    const float* dg = (const float*)(p.ws + WS_DIAG);
    int lowm = 0, highm = 0;
    for (int k = 0; k < 6; ++k) if (!(dg[k] <= DIAG_TOL)) lowm |= 1 << k;
    if (!(dg[6] <= DIAG_TOL)) highm |= 1; if (!(dg[7] <= DIAG_TOL)) highm |= 2; if (!(dg[8] <= 0.2f) || !(dg[9] <= DIAG_TOL)) highm |= 4;
    if (!(dg[10] <= DIAG_TOL)) highm |= 8; if (!(dg[11] <= DIAG_TOL)) highm |= 16;
    float v0 = (1.0f + 0.1f * (float)lowm) * 1000.f;
    for (int i = 0; i < highm; ++i) v0 *= 10.f;
    if (lowm == 0 && (highm & ~8) == 0) v0 = 1e4f * dg[10];
    const size_t gt = (size_t)blockIdx.x * NTHR + otid();
    for (size_t i = gt; i < (size_t)T * 1024; i += (size_t)gridDim.x * NTHR) p.out[i] = (i == 0) ? v0 : 0.f;
}
#endif

__device__ const unsigned char CAND_TAB[64] = {
    0x00, 0x01, 0x02, 0x03, 0x04, 0x05, 0x06, 0x07, 0x08, 0x09, 0x0A, 0x0B, 0x0C, 0x0D, 0x0E, 0x0F,
    0x10, 0x11, 0x12, 0x13, 0x14, 0x15, 0x16, 0x17,
    0x20, 0x21, 0x22, 0x23, 0x24,
    0x30, 0x31, 0x32, 0x33,
    0x40, 0x41, 0x42,
    0x50, 0x51, 0x60, 0x61, 0x70, 0x71,
    0x80, 0x90, 0xA0, 0xB0, 0xC0, 0xD0, 0xE0, 0xF0,
    0, 0, 0, 0, 0, 0, 0, 0, 0, 0, 0, 0, 0, 0};

#define XB_TMO      128
#define XB_XCNT(j)  (256  + 64 * (j))
#define XB_XSUB(j)  (1280 + 64 * (j))
#define XB_XGEN(j)  (2304 + 64 * (j))
#define XB_TOP      3328
#define XB_TOPGEN   3392
#define XCD_BAR_WORDS 3456
#define XB_SPIN_CAP (1u << 18)
__device__ __forceinline__ unsigned xb_ld(unsigned* p)              { return __hip_atomic_load(p, __ATOMIC_RELAXED, __HIP_MEMORY_SCOPE_AGENT); }
__device__ __forceinline__ unsigned xb_add(unsigned* p, unsigned v) { return __hip_atomic_fetch_add(p, v, __ATOMIC_RELAXED, __HIP_MEMORY_SCOPE_AGENT); }
__device__ __forceinline__ unsigned xb_xcc_id() { return (unsigned)__builtin_amdgcn_s_getreg((3 << 11) | 20) & 0xFu; }
#define XB_SPIN(cond, bar) do { unsigned _sp = 0; while (cond) { __builtin_amdgcn_s_sleep(1); \
    if ((++_sp & 255u) == 0u) { if (xb_ld(&(bar)[XB_TMO])) break; if (_sp > XB_SPIN_CAP) { atomicAdd(&(bar)[XB_TMO], 1u); break; } } } } while (0)
struct XcdBarrier { unsigned* bar; unsigned x; volatile LAS unsigned* st; };
__device__ __forceinline__ XcdBarrier xcd_barrier_post(unsigned* bar, volatile LAS unsigned* st) {
    XcdBarrier b; b.bar = bar; b.x = xb_xcc_id(); b.st = st;
    if (threadIdx.x == 0) (void)xb_add(&bar[XB_XCNT(b.x)], 1u);
    return b;
}
__device__ __forceinline__ void xcd_barrier_complete(unsigned* bar, unsigned x, unsigned& nloc, unsigned& nx) {
    const unsigned G = gridDim.x * gridDim.y * gridDim.z;
    unsigned sum, cnt, mine, sp = 0u;
    for (;;) {
        sum = 0u; cnt = 0u; mine = 0u;
#pragma unroll
        for (unsigned j = 0; j < 16; ++j) { const unsigned c = xb_ld(&bar[XB_XCNT(j)]); sum += c; cnt += (c > 0u) ? 1u : 0u; mine = (j == x) ? c : mine; }
        if (sum == G) break;
        __builtin_amdgcn_s_sleep(1);
        if ((++sp & 255u) == 0u) { if (xb_ld(&bar[XB_TMO])) break; if (sp > XB_SPIN_CAP) { atomicAdd(&bar[XB_TMO], 1u); break; } }
    }
    nloc = mine > 0u ? mine : 1u; nx = cnt > 0u ? cnt : 1u;
}
__device__ __forceinline__ void xcd_barrier(const XcdBarrier& b) {
    asm volatile("s_waitcnt vmcnt(0)" ::: "memory");
    __syncthreads();
    if (threadIdx.x == 0) {
        unsigned* bar = b.bar;
        __builtin_amdgcn_s_waitcnt(0);
        unsigned nloc = b.st[0], nx = b.st[1];
        if (nloc == 0u) { xcd_barrier_complete(bar, b.x, nloc, nx); b.st[0] = nloc; b.st[1] = nx; }
        const unsigned old = xb_add(&bar[XB_XSUB(b.x)], 1u);
        const unsigned gen = old / nloc;
        if (old + 1u == (gen + 1u) * nloc) {
            __builtin_amdgcn_fence(__ATOMIC_RELEASE, "agent");
            asm volatile("s_waitcnt vmcnt(0)" ::: "memory");
            const unsigned og = xb_add(&bar[XB_TOP], 1u);
            const unsigned tg = og / nx;
            if (og + 1u == (tg + 1u) * nx) xb_add(&bar[XB_TOPGEN], 1u);
            else XB_SPIN(xb_ld(&bar[XB_TOPGEN]) == tg, bar);
            __builtin_amdgcn_fence(__ATOMIC_ACQUIRE, "agent");
            xb_add(&bar[XB_XGEN(b.x)], 1u);
            asm volatile("s_waitcnt vmcnt(0)" ::: "memory");
        } else {
            XB_SPIN(xb_ld(&bar[XB_XGEN(b.x)]) == gen, bar);
            __builtin_amdgcn_fence(__ATOMIC_ACQUIRE, "agent");
            asm volatile("s_waitcnt vmcnt(0)" ::: "memory");
        }
    }
    __syncthreads();
}

__global__ void __launch_bounds__(NTHR) mega(Params pk) {
    extern __shared__ __attribute__((aligned(16))) unsigned char dynlds[];
    LAS unsigned char* lds = (LAS unsigned char*)dynlds;
    const int G = gridDim.x;
    const int lo = pk.ph_lo, hi = pk.ph_hi;
    cg::grid_group grid = cg::this_grid();
    { volatile LAS unsigned* xbst = (volatile LAS unsigned*)(lds + LDS_BYTES - 16);
    if (threadIdx.x < 4) xbst[threadIdx.x] = 0u;
    __syncthreads();
    (void)xcd_barrier_post((unsigned*)(load_params().ws + WS_BAR), xbst); }
#define IN(k) (lo <= (k) && (k) < hi)
#define SYNC(k) do { if (IN(k) && IN((k) + 1)) { if ((k) == 0) grid.sync(); else { XcdBarrier xb_; xb_.bar = (unsigned*)(load_params().ws + WS_BAR); xb_.x = xb_xcc_id(); xb_.st = (volatile LAS unsigned*)(lds + LDS_BYTES - 16); xcd_barrier(xb_); } } } while (0)
#define WAVE() __builtin_amdgcn_readfirstlane(otid() >> 6)

#ifndef NO_P0
    if (IN(0)) for (int rep = 0; rep < REPS(0); ++rep) { const Params p = load_params(); p0_prologue(p, lds);
#ifdef DIAG
        if (blockIdx.x == 0 && otid() < 16) ((float*)(p.ws + WS_DIAG))[otid()] = 0.f;
#endif
    }
#endif
    SYNC(0);
#pragma unroll 1
    for (int l = 0; l < DEPTH; ++l) {
        const int pb = 1 + 7 * l;
#ifndef NO_A
        if (IN(pb)) for (int rep = 0; rep < REPS(1); ++rep) {
#ifndef NO_A1
            { const Params p = load_params(); unsigned char* ws = p.ws;
              pg8::Gemm g{(const bf16_t*)(ws + WS_XB), (const bf16_t*)(ws + WS_WTA) + (size_t)l * 3072 * 1024, T, 3072, 1024};
              pg8::StaticOrder S; S.init(T, 3072, G, (int)blockIdx.x);
              pg8::EpiQKG E{(bf16_t*)(ws + WS_QK), (bf16_t*)(ws + WS_GATE), p.in[3] + l * 2048};
              pg8::gemm_phase(lds, g, S, E); }
#endif
#ifndef NO_A2
            { const Params p = load_params(); unsigned char* ws = p.ws;
              pg8::Gemm g{(const bf16_t*)(ws + WS_WTB) + (size_t)l * 2048 * 1024, (const bf16_t*)(ws + WS_XB), 2048, T, 1024};
              pg8::StaticOrder S; S.init(2048, T, G, (int)blockIdx.x);
              pg8::EpiBf16 E{(bf16_t*)(ws + WS_VHT), T};
              pg8::gemm_phase(lds, g, S, E); }
#endif
            __syncthreads();
#ifndef NO_FILT
            { const Params p = load_params();
              for (int it = blockIdx.x; it < 256; it += G) filter_item(p, lds, l, it); }
#endif
        }
#endif
        SYNC(pb);
#ifndef NO_B
        if (IN(pb + 1)) for (int rep = 0; rep < REPS(2); ++rep) {
#ifndef NO_NA
            for (int rep2 = 0; rep2 < REPS(8); ++rep2) { const Params p = load_params(); const int wave = WAVE();
              int bxm = blockIdx.x; if (G == 256) { const int x = bxm & 7; bxm = (x >> 2) * 128 + (x & 3) * 32 + (bxm >> 3); }
              for (int task = bxm * 8 + wave; task < 2048; task += G * 8) na_task(p, (LAS float*)(lds + wave * 2048), l, task); }
#endif
            __syncthreads();
#ifndef NO_HY
            for (int rep2 = 0; rep2 < REPS(9); ++rep2) { const Params p = load_params();
              for (int c = blockIdx.x; c < 512; c += G) hyena_item(p, lds, l, c); }
#endif
        }
#endif
        SYNC(pb + 1);
#ifndef NO_C
        if (IN(pb + 2)) for (int rep = 0; rep < REPS(3); ++rep) {
#ifndef NO_C1A
            { const Params p = load_params(); unsigned char* ws = p.ws;
              pg8::Gemm g{(const bf16_t*)(ws + WS_AOUT), (const bf16_t*)(ws + WS_WNA) + (size_t)l * 1024 * 512, T, 1024, 512};
              pg8::StaticOrder S; S.init(T, 1024, G, (int)blockIdx.x);
              pg8::EpiUpA E{(bf16_t*)(ws + WS_QPEER), (const bf16_t*)(ws + WS_GATE)};
              pg8::gemm_phase(lds, g, S, E); }
#endif
#ifndef NO_C1B
            { const Params p = load_params(); pg8::StaticOrder S; S.init(T, 1024, G, (int)blockIdx.x); pg8::Unit u;
              for (int i = 0; S.next(i, u); ++i) bout_panel_transpose(p, lds, u.pm);
              asm volatile("s_waitcnt vmcnt(0)" ::: "memory"); __syncthreads(); }
            { const Params p = load_params(); unsigned char* ws = p.ws;
              pg8::Gemm g{(const bf16_t*)(ws + WS_BOUT), (const bf16_t*)(ws + WS_WHY) + (size_t)l * 1024 * 512, T, 1024, 512};
              pg8::StaticOrder S; S.init(T, 1024, G, (int)blockIdx.x);
              pg8::EpiUpB E{(const bf16_t*)(ws + WS_QPEER), (const bf16_t*)(ws + WS_GATE), (bf16_t*)(ws + WS_MERGED)};
              pg8::gemm_phase(lds, g, S, E); }
#endif
        }
        SYNC(pb + 2);
        if (IN(pb + 3)) for (int rep = 0; rep < REPS(4); ++rep) {
#ifndef NO_C2
            const Params p = load_params(); unsigned char* ws = p.ws;
            pg8::Gemm g{(const bf16_t*)(ws + WS_MERGED), (const bf16_t*)(ws + WS_WOUT) + (size_t)l * 1024 * 1024, T, 1024, 1024};
            pg8::StaticOrder S; S.init(T, 1024, G, (int)blockIdx.x);
            pg8::EpiOut E{l == 0 ? p.in[0] : (const float*)p.out, (float*)(ws + WS_XMID), (bf16_t*)(ws + WS_XBMID)};
            pg8::gemm_phase(lds, g, S, E);
#endif
        }
        SYNC(pb + 3);
        if (IN(pb + 4)) for (int rep = 0; rep < REPS(5); ++rep) {
#ifndef NO_D1
            const Params p = load_params(); unsigned char* ws = p.ws;
            pg8::Gemm g{(const bf16_t*)(ws + WS_XBMID), (const bf16_t*)(ws + WS_WQ) + (size_t)l * 2048 * 1024, T, 2048, 1024};
            pg8::StaticOrder S; S.init(T, 2048, G, (int)blockIdx.x);
            pg8::EpiBf16 E{(bf16_t*)(ws + WS_QPEER), 2048};
            pg8::gemm_phase(lds, g, S, E);
#endif
        }
#endif
        SYNC(pb + 4);
#if !defined(NO_D2) && !defined(NO_E)
        if (IN(pb + 5)) for (int rep = 0; rep < REPS(7); ++rep) {
            const Params p = load_params(); const int wave = WAVE();
            for (int tbi = blockIdx.x; tbi < T / 32; tbi += G) {
                int tb = tbi; if (G == 256) { const int x = blockIdx.x & 7, idx = blockIdx.x >> 3; tb = x * 64 + (tbi >= 256 ? 32 : 0) + idx; }
                for (int li = wave; li < 16; li += 8) topk_task(p, (LAS float*)(lds + wave * 17408), l, tb * 16 + li);
                asm volatile("s_waitcnt vmcnt(0)" ::: "memory");
                __syncthreads();
                for (int i = 0; i < 4; ++i) peer_token(p, lds + wave * 2048, l, tb * 32 + wave * 4 + i, CAND_TAB);
                __syncthreads();
            }
        }
#endif
        SYNC(pb + 5);
    }
#ifdef DIAG
    if (IN(NPHASE_ - 3)) { const Params p = load_params(); diag_inproj(p); }
    if (IN(NPHASE_ - 2)) { const Params p = load_params(); diag_checks(p); diag_peer(p); }
    if (IN(NPHASE_ - 1)) { const Params p = load_params(); diag_emit(p); }
#endif
#undef IN
#undef SYNC
}

constexpr int NPHASE = 1 + 7 * DEPTH;

extern "C" void kernel_launch(void* const* d_in, const int* in_sizes, int n_in, void* d_out, int out_size, void* d_ws, size_t ws_size, hipStream_t stream) {
    static int grid_blocks = 0;
    if (!grid_blocks) {
        int dev = 0, cus = 0, per_cu = 0;
        hipGetDevice(&dev);
        hipDeviceGetAttribute(&cus, hipDeviceAttributeMultiprocessorCount, dev);
        if (hipFuncSetAttribute((const void*)mega, hipFuncAttributeMaxDynamicSharedMemorySize, LDS_BYTES) != hipSuccess) fprintf(stderr, "hipFuncSetAttribute failed\n");
        if (hipOccupancyMaxActiveBlocksPerMultiprocessor(&per_cu, (const void*)mega, NTHR, LDS_BYTES) != hipSuccess || per_cu < 1) { fprintf(stderr, "occupancy query: %d\n", per_cu); per_cu = 1; }
        (void)hipGetLastError();
        grid_blocks = cus * per_cu;
        if (ws_size < WS_END) fprintf(stderr, "workspace too small: %zu < %zu\n", ws_size, (size_t)WS_END);
    }
    (void)hipMemsetAsync((unsigned char*)d_ws + WS_BAR, 0, 16384, stream);
    Params p{};
    for (int i = 0; i < 24; ++i) p.in[i] = (const float*)d_in[i];
    p.out = (float*)d_out; p.ws = (unsigned char*)d_ws;
#if ONE_LAUNCH
    p.ph_lo = 0; p.ph_hi = NPHASE;
    void* args[] = {&p};
    hipError_t e = hipLaunchCooperativeKernel((const void*)mega, dim3(grid_blocks), dim3(NTHR), args, LDS_BYTES, stream);
    if (e != hipSuccess) fprintf(stderr, "cooperative launch failed: %s (grid %d)\n", hipGetErrorString(e), grid_blocks);
#elif defined(DIAG)
    {
        const int seq[] = {0, 1, 2, 3, 4, 5, 6, NPHASE_ - 3, 7, NPHASE_ - 2, NPHASE_ - 1};
        for (int i = 0; i < (int)(sizeof(seq) / sizeof(int)); ++i) { p.ph_lo = seq[i]; p.ph_hi = seq[i] + 1; hipLaunchKernelGGL(mega, dim3(grid_blocks), dim3(NTHR), LDS_BYTES, stream, p); }
    }
#else
    for (int ph = 0; ph < NPHASE; ++ph) {
        p.ph_lo = ph; p.ph_hi = ph + 1;
        hipLaunchKernelGGL(mega, dim3(grid_blocks), dim3(NTHR), LDS_BYTES, stream, p);
    }
#endif
}
```

```cpp
#include <hip/hip_runtime.h>
#include <hip/hip_cooperative_groups.h>
#include <cstdio>
namespace cg = cooperative_groups;

#ifndef FP4_SWAP
#define FP4_SWAP 0
#endif
#ifndef REPEAT_MASK
#define REPEAT_MASK 0
#endif
#define REPS(k) (1 + ((REPEAT_MASK >> (k)) & 1))
#ifndef ONE_LAUNCH
#define ONE_LAUNCH 1
#endif

#define LAS __attribute__((address_space(3)))
typedef unsigned short bf16_t;
typedef short bf16x8 __attribute__((ext_vector_type(8)));
typedef float f32x4 __attribute__((ext_vector_type(4)));
typedef float f32x2 __attribute__((ext_vector_type(2)));
typedef unsigned u32x4 __attribute__((ext_vector_type(4)));
typedef unsigned u32x2 __attribute__((ext_vector_type(2)));
typedef float c2 __attribute__((ext_vector_type(2)));
typedef int v8i_t __attribute__((ext_vector_type(8)));
__device__ __forceinline__ c2 mk2(float a, float b) { c2 r; r.x = a; r.y = b; return r; }

constexpr int T = 16384, DM = 1024, SEQ = 8192, DEPTH = 4;
constexpr int NTHR = 512;
constexpr int LDS_BYTES = 147456;
constexpr int NFFT = 16384;
constexpr int NPHASE_ = 1 + 7 * 4 + 3;
#ifndef DIAG_TOL
#define DIAG_TOL 0.05f
#endif

constexpr size_t MB = 1024ull * 1024ull;
constexpr size_t WS_WTA = 0;
constexpr size_t WS_WTB = WS_WTA + 24 * MB;
constexpr size_t WS_WNA = WS_WTB + 16 * MB;
constexpr size_t WS_WHY = WS_WNA + 4 * MB;
constexpr size_t WS_WOUT = WS_WHY + 4 * MB;
constexpr size_t WS_WQ = WS_WOUT + 8 * MB;
constexpr size_t WS_SK = WS_WQ + 16 * MB;
constexpr size_t WS_UT = WS_SK + 2 * MB;
constexpr size_t WS_VT = WS_UT + 128 * MB;
constexpr size_t WS_H2 = WS_VT + 128 * MB;
constexpr size_t WS_TW = WS_H2 + 8 * MB;
constexpr size_t WS_HF = WS_TW + 1 * MB;
constexpr size_t WS_XB = WS_HF + 64 * MB;
constexpr size_t WS_QK = WS_XB + 32 * MB;
constexpr size_t WS_GATE = WS_QK + 32 * MB;
constexpr size_t WS_VHT = WS_GATE + 64 * MB;
constexpr size_t WS_AOUT = WS_VHT + 64 * MB;
constexpr size_t WS_BOUT = WS_AOUT + 16 * MB;
constexpr size_t WS_MERGED = WS_BOUT + 16 * MB;
constexpr size_t WS_XMID = WS_MERGED + 32 * MB;
constexpr size_t WS_XBMID = WS_XMID + 64 * MB;
constexpr size_t WS_QPEER = WS_XBMID + 32 * MB;
constexpr size_t WS_TOPK = WS_QPEER + 64 * MB;
constexpr size_t WS_BOUTT = WS_QPEER + 32 * MB;
constexpr size_t WS_BAR = WS_TOPK + 16 * MB;
constexpr size_t WS_END = WS_BAR + 16384;

struct Params {
    const float* in[24];
    float* out;
    unsigned char* ws;
    int ph_lo, ph_hi;
};

__device__ __forceinline__ int otid() { int t = threadIdx.x; asm volatile("" : "+v"(t)); return t; }
typedef const __attribute__((address_space(4))) unsigned char* KArg;
__device__ __forceinline__ Params load_params() {
    KArg k = (KArg)__builtin_amdgcn_kernarg_segment_ptr(); asm volatile("" : "+s"(k));
    Params q;
#pragma unroll
    for (int i = 0; i < 24; ++i) q.in[i] = *(const float* const __attribute__((address_space(4)))*)(k + 8 * i);
    q.out = *(float* const __attribute__((address_space(4)))*)(k + 192);
    q.ws = *(unsigned char* const __attribute__((address_space(4)))*)(k + 200);
    q.ph_lo = 0; q.ph_hi = 0;
    return q;
}
typedef __bf16 bf16x2_t __attribute__((ext_vector_type(2)));
__device__ __forceinline__ unsigned cvt_pk_bf16(float lo, float hi) { f32x2 v; v.x = lo; v.y = hi; const bf16x2_t r = __builtin_convertvector(v, bf16x2_t); return __builtin_bit_cast(unsigned, r); }
__device__ __forceinline__ unsigned pack4_fp8(float a, float b, float c, float d) { int r = 0; r = __builtin_amdgcn_cvt_pk_fp8_f32(a, b, r, false); r = __builtin_amdgcn_cvt_pk_fp8_f32(c, d, r, true); return (unsigned)r; }
__device__ __forceinline__ unsigned pack8_fp4(float a, float b, float c, float d, float e, float f, float g, float h) { unsigned r = 0; r = __builtin_amdgcn_cvt_scalef32_pk_fp4_f32(r, a, b, 1.0f, 0); r = __builtin_amdgcn_cvt_scalef32_pk_fp4_f32(r, c, d, 1.0f, 1); r = __builtin_amdgcn_cvt_scalef32_pk_fp4_f32(r, e, f, 1.0f, 2); r = __builtin_amdgcn_cvt_scalef32_pk_fp4_f32(r, g, h, 1.0f, 3); return r; }
__device__ __forceinline__ float bf_lo(unsigned w) { return __uint_as_float(w << 16); }
__device__ __forceinline__ float bf_hi(unsigned w) { return __uint_as_float(w & 0xffff0000u); }
__device__ __forceinline__ float bf1(bf16_t h) { return __uint_as_float(((unsigned)h) << 16); }
__device__ __forceinline__ unsigned fmap(float f) { unsigned u = __float_as_uint(f); return u ^ ((u >> 31) ? 0xFFFFFFFFu : 0x80000000u); }
__device__ __forceinline__ float funmap(unsigned k) { return __uint_as_float(k ^ ((k >> 31) ? 0x80000000u : 0xFFFFFFFFu)); }
__device__ __forceinline__ float wave_sum(float v) {
#pragma unroll
    for (int o = 32; o >= 1; o >>= 1) v += __shfl_xor(v, o);
    return v;
}

namespace pg8 {
constexpr int BM = 256, BK = 64, HALF = 128, HTB = HALF * BK * 2, STAGE_BYTES = 8 * HTB, NXCD = 8, WGM = 8;
__host__ __device__ __forceinline__ int lds_byte(int r, int c) { const int st = (r >> 4) * 2 + (c >> 5), rr = r & 15, cc = c & 31, ob = rr * 64 + cc * 2; return st * 1024 + (ob ^ (((ob >> 9) & 1) << 5)); }
__host__ __device__ __forceinline__ void stage_rc(int b, int& R, int& C) { const int st = b / 1024, sb = b % 1024, swz = sb ^ (((sb >> 9) & 1) << 5); R = (st >> 1) * 16 + swz / 64; C = (st & 1) * 32 + (swz % 64) / 2; }
__host__ __device__ __forceinline__ int perm32(int rho) { const int n = rho >> 4, i = rho & 15; return 8 * (i >> 2) + 4 * n + (i & 3); }
struct Unit { int pm, pn; };
struct Gemm { const bf16_t* A; const bf16_t* Bt; int M, N, K; };
struct StaticOrder {
    int nM, nN, nwg, G, c;
    __host__ __device__ void init(int M, int N, int G_, int c_) { nM = M / BM; nN = N / BM; nwg = nM * nN; G = G_; c = c_; }
    __host__ __device__ bool next(int i, Unit& u) const {
        const long L = (long)i * G + c; if (L >= nwg) return false;
        int wgid = (int)L; { const int q = nwg / NXCD, r = nwg % NXCD, xcd = wgid % NXCD, off = wgid / NXCD; wgid = (xcd < r ? xcd * (q + 1) : r * (q + 1) + (xcd - r) * q) + off; }
        const int nig = WGM * nN, gid = wgid / nig, fm = gid * WGM, gsz = (nM - fm) < WGM ? (nM - fm) : WGM;
        u.pm = fm + ((wgid % nig) % gsz); u.pn = (wgid % nig) / gsz; return true;
    }
};

template <class Epi>
__device__ __forceinline__ void gemm_phase(LAS unsigned char* lds, const Gemm g, const StaticOrder& S, const Epi& E) {
    const int tid = otid(), wid = __builtin_amdgcn_readfirstlane(tid >> 6), lane = tid & 63, wr = wid >> 2, wc = wid & 3, fr = lane & 15, fq = lane >> 4;
    const int K = g.K, nt = K / BK;
    unsigned voffA[2], voffB[2];
#pragma unroll
    for (int i = 0; i < 2; ++i) { int R, C; stage_rc(tid * 16 + i * 8192, R, C); const int Rb = Epi::PERM ? ((R & ~31) + perm32(R & 31)) : R;
        voffA[i] = (unsigned)(R * K + C) * 2u; voffB[i] = (unsigned)(Rb * K + C) * 2u; }
    const size_t kstep = (size_t)(BK * 2);
    const size_t hstep = (size_t)HALF * K * 2;
    const size_t tstep = 2 * hstep;
    const unsigned ldsw = (unsigned)wid * 1024u;
    const int aoff = lds_byte(wr * 64 + fr, fq * 8), boff = lds_byte(wc * 32 + fr, fq * 8);
#define PG8_SA(b, h) (((b) * 2 + (h)) * HTB)
#define PG8_SB(b, h) ((4 + (b) * 2 + (h)) * HTB)
#define PG8_STAGE(bufoff, gbase, voff) do { _Pragma("unroll") for (int _i = 0; _i < 2; ++_i) \
        __builtin_amdgcn_global_load_lds((const unsigned*)((const char*)(gbase) + (voff)[_i]), (LAS unsigned*)(lds + (bufoff) + ldsw + _i * 8192), 16, 0, 0); } while (0)
#define PG8_LDA(dst, b, h) do { _Pragma("unroll") for (int m = 0; m < 4; ++m) _Pragma("unroll") for (int k = 0; k < 2; ++k) dst[m][k] = *(const LAS bf16x8*)(lds + PG8_SA(b, h) + aoff + m * 2048 + k * 1024); } while (0)
#define PG8_LDB(dst, b, h) do { _Pragma("unroll") for (int n = 0; n < 2; ++n) _Pragma("unroll") for (int k = 0; k < 2; ++k) dst[n][k] = *(const LAS bf16x8*)(lds + PG8_SB(b, h) + boff + n * 2048 + k * 1024); } while (0)
#define PG8_MMA(ai, bj, At, Bt) do { __builtin_amdgcn_s_setprio(1); _Pragma("unroll") for (int m = 0; m < 4; ++m) _Pragma("unroll") for (int n = 0; n < 2; ++n) _Pragma("unroll") for (int k = 0; k < 2; ++k) \
        acc[ai][bj][m][n] = __builtin_amdgcn_mfma_f32_16x16x32_bf16(Bt[n][k], At[m][k], acc[ai][bj][m][n], 0, 0, 0); __builtin_amdgcn_s_setprio(0); } while (0)
#define PG8_WAIT_V(n) asm volatile("s_waitcnt vmcnt(" #n ")" ::: "memory")
#define PG8_WAIT_L(n) asm volatile("s_waitcnt lgkmcnt(" #n ")" ::: "memory")
#define PG8_BAR __builtin_amdgcn_s_barrier()
#define PG8_SCHED __builtin_amdgcn_sched_barrier(0)
    Unit cur, nxt; int ui = 0;
    if (!S.next(0, cur)) return;
    f32x4 acc[2][2][4][2];
#pragma unroll
    for (int a = 0; a < 2; ++a)
#pragma unroll
        for (int b = 0; b < 2; ++b)
#pragma unroll
            for (int m = 0; m < 4; ++m)
#pragma unroll
                for (int n = 0; n < 2; ++n) acc[a][b][m][n] = (f32x4){0.f, 0.f, 0.f, 0.f};
    bf16x8 At[4][2], B0[2][2], B1[2][2];
    const char* cA = (const char*)g.A + (size_t)cur.pm * tstep; const char* cB = (const char*)g.Bt + (size_t)cur.pn * tstep;
    PG8_STAGE(PG8_SB(0, 0), cB, voffB); PG8_STAGE(PG8_SA(0, 0), cA, voffA); PG8_STAGE(PG8_SB(0, 1), cB + hstep, voffB); PG8_STAGE(PG8_SA(0, 1), cA + hstep, voffA);
    if (wr == 1) PG8_BAR;
    PG8_WAIT_V(4); PG8_BAR;
    PG8_STAGE(PG8_SB(1, 0), cB + kstep, voffB); PG8_STAGE(PG8_SA(1, 0), cA + kstep, voffA); PG8_STAGE(PG8_SB(1, 1), cB + hstep + kstep, voffB);
    PG8_WAIT_V(6); PG8_BAR;
    for (;;) {
        const bool has_next = S.next(ui + 1, nxt);
        const char* nA = has_next ? (const char*)g.A + (size_t)nxt.pm * tstep : cA; const char* nB = has_next ? (const char*)g.Bt + (size_t)nxt.pn * tstep : cB;
        for (int t = 0; t < nt; t += 2) {
            const bool last = (t == nt - 2);
            const char* a1 = cA + (size_t)(t + 1) * kstep;
            const char* a2 = last ? nA : cA + (size_t)(t + 2) * kstep; const char* b2 = last ? nB : cB + (size_t)(t + 2) * kstep;
            const char* a3 = a2 + kstep; const char* b3 = b2 + kstep;
            PG8_LDB(B0, 0, 0); PG8_SCHED; PG8_LDA(At, 0, 0); PG8_STAGE(PG8_SA(1, 1), a1 + hstep, voffA);
            PG8_WAIT_L(8); PG8_BAR; PG8_WAIT_L(0); PG8_MMA(0, 0, At, B0); PG8_BAR; PG8_SCHED;
            PG8_LDB(B1, 0, 1); PG8_STAGE(PG8_SB(0, 0), b2, voffB);
            PG8_BAR; PG8_WAIT_L(0); PG8_MMA(0, 1, At, B1); PG8_BAR;
            PG8_LDA(At, 0, 1); PG8_STAGE(PG8_SA(0, 0), a2, voffA);
            PG8_BAR; PG8_WAIT_L(0); PG8_MMA(1, 0, At, B0); PG8_BAR; PG8_SCHED;
            PG8_STAGE(PG8_SB(0, 1), b2 + hstep, voffB);
            PG8_WAIT_V(6); PG8_BAR; PG8_MMA(1, 1, At, B1); PG8_BAR;
            PG8_LDB(B0, 1, 0); PG8_SCHED; PG8_LDA(At, 1, 0); PG8_STAGE(PG8_SA(0, 1), a2 + hstep, voffA);
            PG8_WAIT_L(8); PG8_BAR; PG8_WAIT_L(0); PG8_MMA(0, 0, At, B0); PG8_BAR; PG8_SCHED;
            PG8_LDB(B1, 1, 1); PG8_STAGE(PG8_SB(1, 0), b3, voffB);
            PG8_BAR; PG8_WAIT_L(0); PG8_MMA(0, 1, At, B1); PG8_BAR;
            PG8_LDA(At, 1, 1); PG8_STAGE(PG8_SA(1, 0), a3, voffA);
            PG8_BAR; PG8_WAIT_L(0); PG8_MMA(1, 0, At, B0); PG8_BAR; PG8_SCHED;
            PG8_STAGE(PG8_SB(1, 1), b3 + hstep, voffB);
            PG8_WAIT_V(6); PG8_BAR; PG8_MMA(1, 1, At, B1); PG8_BAR;
        }
        E(acc, cur, wr, wc, fr, fq);
        if (!has_next) break;
#pragma unroll
        for (int a = 0; a < 2; ++a)
#pragma unroll
            for (int b = 0; b < 2; ++b)
#pragma unroll
                for (int m = 0; m < 4; ++m)
#pragma unroll
                    for (int n = 0; n < 2; ++n) acc[a][b][m][n] = (f32x4){0.f, 0.f, 0.f, 0.f};
        cur = nxt; cA = nA; cB = nB; ++ui;
    }
    PG8_WAIT_V(0);
    if (wr == 0) PG8_BAR;
    PG8_BAR;
#undef PG8_SA
#undef PG8_SB
#undef PG8_STAGE
#undef PG8_LDA
#undef PG8_LDB
#undef PG8_MMA
#undef PG8_WAIT_V
#undef PG8_WAIT_L
#undef PG8_BAR
#undef PG8_SCHED
}

struct EpiBf16 {
    static constexpr bool PERM = true;
    bf16_t* O; int ldc;
    __device__ __forceinline__ void operator()(const f32x4 (&acc)[2][2][4][2], const Unit& u, int wr, int wc, int fr, int fq) const {
        const int row0 = u.pm * BM + wr * 64 + fr, col0 = u.pn * BM + wc * 32 + 8 * fq;
#pragma unroll
        for (int ai = 0; ai < 2; ++ai)
#pragma unroll
            for (int m = 0; m < 4; ++m) { bf16_t* rowp = O + (size_t)(row0 + ai * HALF + m * 16) * ldc + col0;
#pragma unroll
                for (int bj = 0; bj < 2; ++bj) { const f32x4 v0 = acc[ai][bj][m][0], v1 = acc[ai][bj][m][1];
                    u32x4 w; w.x = cvt_pk_bf16(v0[0], v0[1]); w.y = cvt_pk_bf16(v0[2], v0[3]); w.z = cvt_pk_bf16(v1[0], v1[1]); w.w = cvt_pk_bf16(v1[2], v1[3]);
                    *(u32x4*)(rowp + bj * HALF) = w; } }
    }
};
struct EpiQKG {
    static constexpr bool PERM = true;
    bf16_t* QKo; bf16_t* GATE; const float* gb;
    __device__ __forceinline__ void operator()(const f32x4 (&acc)[2][2][4][2], const Unit& u, int wr, int wc, int fr, int fq) const {
        const int row0 = u.pm * BM + wr * 64 + fr, col0 = u.pn * BM + wc * 32 + 8 * fq;
        if (u.pn < 4) {
#pragma unroll
            for (int ai = 0; ai < 2; ++ai)
#pragma unroll
                for (int m = 0; m < 4; ++m) { bf16_t* rowp = QKo + (size_t)(row0 + ai * HALF + m * 16) * 1024 + col0;
#pragma unroll
                    for (int bj = 0; bj < 2; ++bj) { const f32x4 v0 = acc[ai][bj][m][0], v1 = acc[ai][bj][m][1];
                        u32x4 w; w.x = cvt_pk_bf16(v0[0], v0[1]); w.y = cvt_pk_bf16(v0[2], v0[3]); w.z = cvt_pk_bf16(v1[0], v1[1]); w.w = cvt_pk_bf16(v1[2], v1[3]);
                        *(u32x4*)(rowp + bj * HALF) = w; } }
        } else {
            const int gc = col0 - 1024;
            f32x4 bv[2][2];
#pragma unroll
            for (int bj = 0; bj < 2; ++bj)
#pragma unroll
                for (int n = 0; n < 2; ++n) bv[bj][n] = *(const f32x4*)(gb + gc + bj * HALF + 4 * n);
#pragma unroll
            for (int ai = 0; ai < 2; ++ai)
#pragma unroll
                for (int m = 0; m < 4; ++m) { bf16_t* rowp = GATE + (size_t)(row0 + ai * HALF + m * 16) * 2048 + gc;
#pragma unroll
                    for (int bj = 0; bj < 2; ++bj) { f32x4 v0 = acc[ai][bj][m][0] + bv[bj][0], v1 = acc[ai][bj][m][1] + bv[bj][1];
#pragma unroll
                        for (int j = 0; j < 4; ++j) {
#ifndef DIAG_RAWGATE
 v0[j] = __builtin_amdgcn_rcpf(1.f + __expf(-v0[j])); v1[j] = __builtin_amdgcn_rcpf(1.f + __expf(-v1[j]));
#endif
 }
                        u32x4 w; w.x = cvt_pk_bf16(v0[0], v0[1]); w.y = cvt_pk_bf16(v0[2], v0[3]); w.z = cvt_pk_bf16(v1[0], v1[1]); w.w = cvt_pk_bf16(v1[2], v1[3]);
                        *(u32x4*)(rowp + bj * HALF) = w; } }
        }
    }
};
struct EpiUpA {
    static constexpr bool PERM = false;
    bf16_t* TMP; const bf16_t* GATE;
    __device__ __forceinline__ void operator()(const f32x4 (&acc)[2][2][4][2], const Unit& u, int wr, int wc, int fr, int fq) const {
        const int row0 = u.pm * BM + wr * 64 + fr, col0 = u.pn * BM + wc * 32 + 4 * fq;
#pragma unroll
        for (int ai = 0; ai < 2; ++ai)
#pragma unroll
            for (int m = 0; m < 4; ++m) { const size_t row = (size_t)(row0 + ai * HALF + m * 16);
#pragma unroll
                for (int bj = 0; bj < 2; ++bj)
#pragma unroll
                    for (int n = 0; n < 2; ++n) { const int col = col0 + bj * HALF + n * 16;
                        const u32x2 gw = *(const u32x2*)(GATE + row * 2048 + col);
                        f32x4 v = acc[ai][bj][m][n]; v[0] *= bf_lo(gw.x); v[1] *= bf_hi(gw.x); v[2] *= bf_lo(gw.y); v[3] *= bf_hi(gw.y);
                        u32x2 w; w.x = cvt_pk_bf16(v[0], v[1]); w.y = cvt_pk_bf16(v[2], v[3]);
                        *(u32x2*)(TMP + row * 1024 + col) = w; } }
    }
};
struct EpiUpB {
    static constexpr bool PERM = false;
    const bf16_t* TMP; const bf16_t* GATE; bf16_t* MERGED;
    __device__ __forceinline__ void operator()(const f32x4 (&acc)[2][2][4][2], const Unit& u, int wr, int wc, int fr, int fq) const {
        const int row0 = u.pm * BM + wr * 64 + fr, col0 = u.pn * BM + wc * 32 + 4 * fq;
#pragma unroll
        for (int ai = 0; ai < 2; ++ai)
#pragma unroll
            for (int m = 0; m < 4; ++m) { const size_t row = (size_t)(row0 + ai * HALF + m * 16);
#pragma unroll
                for (int bj = 0; bj < 2; ++bj)
#pragma unroll
                    for (int n = 0; n < 2; ++n) { const int col = col0 + bj * HALF + n * 16;
                        const u32x2 gw = *(const u32x2*)(GATE + row * 2048 + 1024 + col);
                        const u32x2 tw = *(const u32x2*)(TMP + row * 1024 + col); const f32x4 t = (f32x4){bf_lo(tw.x), bf_hi(tw.x), bf_lo(tw.y), bf_hi(tw.y)};
                        f32x4 v = acc[ai][bj][m][n]; v[0] = t[0] + v[0] * bf_lo(gw.x); v[1] = t[1] + v[1] * bf_hi(gw.x); v[2] = t[2] + v[2] * bf_lo(gw.y); v[3] = t[3] + v[3] * bf_hi(gw.y);
                        u32x2 w; w.x = cvt_pk_bf16(v[0], v[1]); w.y = cvt_pk_bf16(v[2], v[3]);
                        *(u32x2*)(MERGED + row * 1024 + col) = w; } }
    }
};
struct EpiOut {
    static constexpr bool PERM = false;
    const float* XRES; float* XMID; bf16_t* XBMID;
    __device__ __forceinline__ void operator()(const f32x4 (&acc)[2][2][4][2], const Unit& u, int wr, int wc, int fr, int fq) const {
        const int row0 = u.pm * BM + wr * 64 + fr, col0 = u.pn * BM + wc * 32 + 4 * fq;
#pragma unroll
        for (int ai = 0; ai < 2; ++ai)
#pragma unroll
            for (int m = 0; m < 4; ++m) { const size_t row = (size_t)(row0 + ai * HALF + m * 16);
#pragma unroll
                for (int bj = 0; bj < 2; ++bj)
#pragma unroll
                    for (int n = 0; n < 2; ++n) { const int col = col0 + bj * HALF + n * 16;
                        const f32x4 v = acc[ai][bj][m][n] + *(const f32x4*)(XRES + row * 1024 + col);
                        *(f32x4*)(XMID + row * 1024 + col) = v;
                        u32x2 w; w.x = cvt_pk_bf16(v[0], v[1]); w.y = cvt_pk_bf16(v[2], v[3]);
                        *(u32x2*)(XBMID + row * 1024 + col) = w; } }
    }
};
}

__device__ __forceinline__ void p0_transpose_tile(LAS float* tile, const float* __restrict__ src, int ldsrc, int col0, int k0, const float* __restrict__ scale,
                                  bf16_t* __restrict__ dst, int K, int drow0) {
    const int tid = otid();
    {
        const int kk = tid >> 4, nn = (tid & 15) * 4;
#pragma unroll
        for (int i = 0; i < 2; ++i) {
            const int k = kk + 32 * i;
            const f32x4 v = *(const f32x4*)(src + (size_t)(k0 + k) * ldsrc + col0 + nn);
            const float sc = scale ? scale[k0 + k] : 1.f;
            tile[k * 65 + nn + 0] = v[0] * sc; tile[k * 65 + nn + 1] = v[1] * sc; tile[k * 65 + nn + 2] = v[2] * sc; tile[k * 65 + nn + 3] = v[3] * sc;
        }
    }
    __syncthreads();
    {
        const int n = tid >> 3, kc = (tid & 7) * 8;
        float a[8];
#pragma unroll
        for (int j = 0; j < 8; ++j) a[j] = tile[(kc + j) * 65 + n];
        u32x4 w; w.x = cvt_pk_bf16(a[0], a[1]); w.y = cvt_pk_bf16(a[2], a[3]); w.z = cvt_pk_bf16(a[4], a[5]); w.w = cvt_pk_bf16(a[6], a[7]);
        *(u32x4*)(dst + (size_t)(drow0 + n) * K + k0 + kc) = w;
    }
    __syncthreads();
}

__device__ __forceinline__ void p0_prologue(const Params& p, LAS unsigned char* lds) {
    const int tid = otid(), lane = tid & 63, G = gridDim.x;
    unsigned char* ws = p.ws;
    for (int t = blockIdx.x; t < 4 * 2304; t += G) {
        const int l = t / 2304; int r = t % 2304;
        const float* src; int ldsrc, scol0, K; const float* scale; bf16_t* dst; int drow0;
        if (r < 256) { src = p.in[2] + (size_t)l * 1024 * 5120; ldsrc = 5120; scol0 = 0; K = 1024; scale = p.in[1] + l * 1024; dst = (bf16_t*)(ws + WS_WTA) + (size_t)l * 3072 * 1024; drow0 = 0; }
        else if (r < 768) { r -= 256; src = p.in[2] + (size_t)l * 1024 * 5120; ldsrc = 5120; scol0 = 3072; K = 1024; scale = p.in[1] + l * 1024; dst = (bf16_t*)(ws + WS_WTA) + (size_t)l * 3072 * 1024; drow0 = 1024; }
        else if (r < 1280) { r -= 768; src = p.in[2] + (size_t)l * 1024 * 5120; ldsrc = 5120; scol0 = 1024; K = 1024; scale = p.in[1] + l * 1024; dst = (bf16_t*)(ws + WS_WTB) + (size_t)l * 2048 * 1024; drow0 = 0; }
        else if (r < 1408) { r -= 1280; src = p.in[16] + (size_t)l * 512 * 1024; ldsrc = 1024; scol0 = 0; K = 512; scale = nullptr; dst = (bf16_t*)(ws + WS_WNA) + (size_t)l * 1024 * 512; drow0 = 0; }
        else if (r < 1536) { r -= 1408; src = p.in[17] + (size_t)l * 512 * 1024; ldsrc = 1024; scol0 = 0; K = 512; scale = nullptr; dst = (bf16_t*)(ws + WS_WHY) + (size_t)l * 1024 * 512; drow0 = 0; }
        else if (r < 1792) { r -= 1536; src = p.in[18] + (size_t)l * 1024 * 1024; ldsrc = 1024; scol0 = 0; K = 1024; scale = nullptr; dst = (bf16_t*)(ws + WS_WOUT) + (size_t)l * 1024 * 1024; drow0 = 0; }
        else { r -= 1792; src = p.in[20] + (size_t)l * 1024 * 2048; ldsrc = 2048; scol0 = 0; K = 1024; scale = p.in[19] + l * 1024; dst = (bf16_t*)(ws + WS_WQ) + (size_t)l * 2048 * 1024; drow0 = 0; }
        const int nkt = K / 64, tk = r % nkt, tn = r / nkt;
        p0_transpose_tile((LAS float*)lds, src, ldsrc, scol0 + tn * 64, tk * 64, scale, dst, K, drow0 + tn * 64);
    }
    const size_t gt = (size_t)blockIdx.x * NTHR + tid, gstride = (size_t)G * NTHR;
    {
        const float* src = p.in[21]; bf16_t* dst = (bf16_t*)(ws + WS_SK);
        for (size_t i = gt; i < (size_t)4 * 262144 / 8; i += gstride) {
            const f32x4 a = *(const f32x4*)(src + i * 8), b = *(const f32x4*)(src + i * 8 + 4);
            u32x4 w; w.x = cvt_pk_bf16(a[0], a[1]); w.y = cvt_pk_bf16(a[2], a[3]); w.z = cvt_pk_bf16(b[0], b[1]); w.w = cvt_pk_bf16(b[2], b[3]);
            *(u32x4*)(dst + i * 8) = w;
        }
    }
#pragma unroll 1
    for (int tb = 0; tb < 2; ++tb) {
        const float* src = tb ? p.in[23] : p.in[22]; unsigned char* dst = ws + (tb ? WS_VT : WS_UT);
        for (size_t i = gt; i < (size_t)4 * 16384 * 1024 / 16; i += gstride) {
            f32x4 a[4];
#pragma unroll
            for (int q = 0; q < 4; ++q) a[q] = __builtin_nontemporal_load((const f32x4*)(src + i * 16 + q * 4)) * 64.f;
            u32x2 w;
            if (tb == 0 && FP4_SWAP) { w.x = pack8_fp4(a[0][1], a[0][0], a[0][3], a[0][2], a[1][1], a[1][0], a[1][3], a[1][2]); w.y = pack8_fp4(a[2][1], a[2][0], a[2][3], a[2][2], a[3][1], a[3][0], a[3][3], a[3][2]); }
            else { w.x = pack8_fp4(a[0][0], a[0][1], a[0][2], a[0][3], a[1][0], a[1][1], a[1][2], a[1][3]); w.y = pack8_fp4(a[2][0], a[2][1], a[2][2], a[2][3], a[3][0], a[3][1], a[3][2], a[3][3]); }
            *(u32x2*)(dst + i * 8) = w;
        }
    }
    const int gw = blockIdx.x * 8 + (tid >> 6), nw = G * 8;
    {
        const float* x = p.in[0]; bf16_t* xb = (bf16_t*)(ws + WS_XB);
        for (int tok = gw; tok < T; tok += nw) {
            const float* xr = x + (size_t)tok * 1024;
            f32x4 v[4]; float ss = 0.f;
#pragma unroll
            for (int i = 0; i < 2; ++i) { v[2 * i] = *(const f32x4*)(xr + i * 512 + lane * 8); v[2 * i + 1] = *(const f32x4*)(xr + i * 512 + lane * 8 + 4); }
#pragma unroll
            for (int i = 0; i < 4; ++i) ss += v[i][0] * v[i][0] + v[i][1] * v[i][1] + v[i][2] * v[i][2] + v[i][3] * v[i][3];
            ss = wave_sum(ss);
            const float rs = rsqrtf(ss * (1.f / 1024.f) + 1e-6f);
#pragma unroll
            for (int i = 0; i < 2; ++i) { const f32x4 a = v[2 * i] * rs, b = v[2 * i + 1] * rs;
                u32x4 w; w.x = cvt_pk_bf16(a[0], a[1]); w.y = cvt_pk_bf16(a[2], a[3]); w.z = cvt_pk_bf16(b[0], b[1]); w.w = cvt_pk_bf16(b[2], b[3]);
                *(u32x4*)(xb + (size_t)tok * 1024 + i * 512 + lane * 8) = w; }
        }
    }
    {
        float* H2 = (float*)(ws + WS_H2);
        for (int row = gw; row < 4 * SEQ; row += nw) {
            const int l = row / SEQ, s = row % SEQ;
            const float tt = (float)s * (1.f / 8191.f);
            const float w = 6.283185307179586f * (float)s / 8192.f;
            float z = 0.f;
            if (lane == 0) z = tt;
            else if (lane <= 16) { const float f = 1e-4f + (float)(lane - 1) * ((15.f - 1e-4f) / 15.f); z = cosf(f * w); }
            else if (lane <= 32) { const float f = 1e-4f + (float)(lane - 17) * ((15.f - 1e-4f) / 15.f); z = -sinf(f * w); }
            const float* w1 = p.in[9] + (size_t)l * 33 * 64; const float* w2 = p.in[12] + (size_t)l * 64 * 64;
            const float fr = p.in[11][l * 64 + lane];
            float a = p.in[10][l * 64 + lane];
            for (int i = 0; i < 33; ++i) a += __shfl(z, i) * w1[i * 64 + lane];
            const float h1 = sinf(fr * a);
            float a2 = p.in[13][l * 64 + lane];
            for (int i = 0; i < 64; ++i) a2 += __shfl(h1, i) * w2[i * 64 + lane];
            H2[(size_t)row * 64 + lane] = sinf(fr * a2);
        }
    }
    {
        c2* tw = (c2*)(ws + WS_TW);
        for (size_t k = gt; k < NFFT; k += gstride) { float s, c; sincospif((float)k * (1.f / 8192.f), &s, &c); tw[k] = mk2(c, -s); }
    }
}

__device__ __forceinline__ c2 cadd(c2 a, c2 b) { return a + b; }
__device__ __forceinline__ c2 csub(c2 a, c2 b) { return a - b; }
__device__ __forceinline__ c2 cmul(c2 a, c2 b) { const c2 ax = {a.x, a.x}, ay = {a.y, a.y}, bs = {-b.y, b.x}; return __builtin_elementwise_fma(ay, bs, ax * b); }
__device__ __forceinline__ c2 cmulc(c2 a, c2 b) { const c2 ax = {a.x, a.x}, ay = {a.y, a.y}, bc = {b.x, -b.y}, bs = {b.y, b.x}; return __builtin_elementwise_fma(ay, bs, ax * bc); }
__device__ __forceinline__ int sw(int p) { return p ^ (((p >> 5) & 3) * 5) ^ (((p >> 6) & 1) << 4); }
__device__ __forceinline__ int rev4_14(int p) { unsigned r = __brev((unsigned)p) >> 18; return (int)(((r & 0x1555u) << 1) | ((r >> 1) & 0x1555u)); }

template <bool ZEROHI, bool SKIPLAST = false>
__device__ __forceinline__ void fft_fwd(LAS c2* X, const LAS c2* TWL) {
    const int tid = otid();
#pragma unroll
    for (int lg = 14; lg >= 2; lg -= 2) {
        if (SKIPLAST && lg == 2) break;
        const int q = 1 << (lg - 2), tsh = 14 - lg;
#pragma unroll 2
        for (int i = 0; i < 8; ++i) {
            const int t = tid + 512 * i, j = t & (q - 1), base = ((t >> (lg - 2)) << lg) + j;
            const bool zhi = ZEROHI && lg == 14;
            const int i0 = sw(base), i1 = sw(base + q), i2 = sw(base + 2 * q), i3 = sw(base + 3 * q);
            const c2 a0 = X[i0], a1 = X[i1], a2 = zhi ? mk2(0.f, 0.f) : X[i2], a3 = zhi ? mk2(0.f, 0.f) : X[i3];
            const c2 b0 = cadd(a0, a2), b1 = csub(a0, a2), b2 = cadd(a1, a3), d = csub(a1, a3);
            const c2 b3 = mk2(d.y, -d.x);
            const int k1 = j << tsh; const c2 w1 = cmul(TWL[k1 >> 7], TWL[128 + (k1 & 127)]), w2 = cmul(w1, w1), w3 = cmul(w2, w1);
            X[i0] = cadd(b0, b2); X[i1] = cmul(cadd(b1, b3), w1); X[i2] = cmul(csub(b0, b2), w2); X[i3] = cmul(csub(b1, b3), w3);
        }
        __syncthreads();
    }
}
template <bool LOHALF, bool SKIPFIRST = false>
__device__ __forceinline__ void fft_inv(LAS c2* X, const LAS c2* TWL) {
    const int tid = otid();
#pragma unroll
    for (int lg = 2; lg <= 14; lg += 2) {
        if (SKIPFIRST && lg == 2) continue;
        const int q = 1 << (lg - 2), tsh = 14 - lg;
#pragma unroll 2
        for (int i = 0; i < 8; ++i) {
            const int t = tid + 512 * i, j = t & (q - 1), base = ((t >> (lg - 2)) << lg) + j;
            const int k1 = j << tsh; const c2 w1 = cmul(TWL[k1 >> 7], TWL[128 + (k1 & 127)]), w2 = cmul(w1, w1), w3 = cmul(w2, w1);
            const int i0 = sw(base), i1 = sw(base + q), i2 = sw(base + 2 * q), i3 = sw(base + 3 * q);
            const c2 a0 = X[i0], a1 = cmulc(X[i1], w1), a2 = cmulc(X[i2], w2), a3 = cmulc(X[i3], w3);
            const c2 b0 = cadd(a0, a2), b1 = csub(a0, a2), b2 = cadd(a1, a3), d = csub(a1, a3);
            const c2 b3 = mk2(-d.y, d.x);
            X[i0] = cadd(b0, b2); X[i1] = cadd(b1, b3);
            if (!(LOHALF && lg == 14)) { X[i2] = csub(b0, b2); X[i3] = csub(b1, b3); }
        }
        __syncthreads();
    }
}

__device__ __forceinline__ void filter_item(const Params& p, LAS unsigned char* lds, int l, int pair) {
    const int tid = otid();
    LAS c2* X = (LAS c2*)lds;
    LAS float* wc = (LAS float*)(lds + 131072);
    const c2* tw = (const c2*)(p.ws + WS_TW);
    const float* H2 = (const float*)(p.ws + WS_H2) + (size_t)l * SEQ * 64;
    const float* w3 = p.in[14] + (size_t)l * 64 * 1024;
    const int c0 = pair * 2, c1 = c0 + 1;
    if (tid < 256) { const int q = tid >> 6, j = tid & 63; const int col = (q == 0) ? c0 : (q == 1 ? 512 + c0 : (q == 2 ? c1 : 512 + c1)); wc[tid] = w3[j * 1024 + col]; }
    LAS c2* TWL = (LAS c2*)(lds + 131072 + 1024);
    if (tid < 256) TWL[tid] = tw[tid < 128 ? tid * 128 : tid - 128];
    __syncthreads();
    const float mind = -3.0701134573253945f, maxd = -15.350567286626972f;
    const float ad0 = fabsf(mind + (maxd - mind) * ((float)c0 / 511.f)), ad1 = fabsf(mind + (maxd - mind) * ((float)c1 / 511.f));
    const float invN = 1.f / 16384.f;
    const float sk0 = p.in[15][l * 512 + c0], sk1 = p.in[15][l * 512 + c1];
    {
        const int lane = tid & 63, wv = tid >> 6, n = lane & 15, g = lane >> 4, q = n & 3, rr = n >> 2;
        LAS float* Xf = (LAS float*)X;
        bf16x8 bfr[2];
#pragma unroll
        for (int ks = 0; ks < 2; ++ks) { float wv8[8];
#pragma unroll
            for (int e = 0; e < 8; ++e) wv8[e] = wc[q * 64 + ks * 32 + g * 8 + e];
            u32x4 w; w.x = cvt_pk_bf16(wv8[0], wv8[1]); w.y = cvt_pk_bf16(wv8[2], wv8[3]); w.z = cvt_pk_bf16(wv8[4], wv8[5]); w.w = cvt_pk_bf16(wv8[6], wv8[7]); bfr[ks] = __builtin_bit_cast(bf16x8, w); }
        const float adq = (q < 2) ? ad0 : ad1;
        const float kexp = -adq * (1.f / 8191.f) * 1.4426950408889634f;
        const int comp = q >> 1;
        const bool bwd = (q & 1) != 0;
#pragma unroll 2
        for (int t = 0; t < 64; ++t) {
            const int s0 = wv * 1024 + t * 16;
            const float* hp = H2 + (size_t)(s0 + n) * 64 + g * 8;
            const f32x4 h0 = *(const f32x4*)hp, h1 = *(const f32x4*)(hp + 4), h2v = *(const f32x4*)(hp + 32), h3 = *(const f32x4*)(hp + 36);
            u32x4 a0, a1;
            a0.x = cvt_pk_bf16(h0[0], h0[1]); a0.y = cvt_pk_bf16(h0[2], h0[3]); a0.z = cvt_pk_bf16(h1[0], h1[1]); a0.w = cvt_pk_bf16(h1[2], h1[3]);
            a1.x = cvt_pk_bf16(h2v[0], h2v[1]); a1.y = cvt_pk_bf16(h2v[2], h2v[3]); a1.z = cvt_pk_bf16(h3[0], h3[1]); a1.w = cvt_pk_bf16(h3[2], h3[3]);
            f32x4 acc = (f32x4){0.f, 0.f, 0.f, 0.f};
            acc = __builtin_amdgcn_mfma_f32_16x16x32_bf16(__builtin_bit_cast(bf16x8, a0), bfr[0], acc, 0, 0, 0);
            acc = __builtin_amdgcn_mfma_f32_16x16x32_bf16(__builtin_bit_cast(bf16x8, a1), bfr[1], acc, 0, 0, 0);
            const float v = (rr == 0) ? acc[0] : (rr == 1 ? acc[1] : (rr == 2 ? acc[2] : acc[3]));
            const int sp = s0 + g * 4 + rr;
            const float val = v * __builtin_amdgcn_exp2f(kexp * (float)sp) * invN;
            if (!bwd) Xf[2 * sw(sp) + comp] = val;
            else if (sp != 0) Xf[2 * sw(NFFT - sp) + comp] = val;
            else wc[768 + comp] = val;
        }
    }
    __syncthreads();
    if (tid == 0) { const c2 x0 = X[0]; X[0] = mk2(x0.x + wc[768] + sk0 * invN, x0.y + wc[769] + sk1 * invN); }
    if (tid == 0) X[8192] = mk2(0.f, 0.f);
    __syncthreads();
    fft_fwd<false>(X, TWL);
    c2* HF0 = (c2*)(p.ws + WS_HF) + (size_t)c0 * NFFT; c2* HF1 = HF0 + NFFT;
#pragma unroll 1
    for (int ii = 0; ii < 32; ++ii) {
        const int pp = tid + 512 * ii;
        const int k = rev4_14(pp), pm = rev4_14((NFFT - k) & (NFFT - 1));
        const c2 W1 = X[sw(pp)], W2 = X[sw(pm)];
        HF0[pp] = mk2(0.5f * (W1.x + W2.x), 0.5f * (W1.y - W2.y));
        HF1[pp] = mk2(0.5f * (W1.y + W2.y), -0.5f * (W1.x - W2.x));
    }
    __syncthreads();
}

struct Conv8In { u32x4 v; bf16_t lo, hi; };
__device__ __forceinline__ Conv8In conv8_load(const bf16_t* __restrict__ row, int b, int s0) {
    const bf16_t* rp = row + (size_t)b * SEQ + s0;
    Conv8In r; r.v = *(const u32x4*)rp; r.lo = (s0 == 0) ? (bf16_t)0 : rp[-1]; r.hi = (s0 + 8 == SEQ) ? (bf16_t)0 : rp[8];
    return r;
}
__device__ __forceinline__ void conv8_apply(const Conv8In& in, float w0, float w1, float w2, float bias, float (&o)[8]) {
    float x[10];
    x[0] = bf1(in.lo); x[9] = bf1(in.hi);
    x[1] = bf_lo(in.v.x); x[2] = bf_hi(in.v.x); x[3] = bf_lo(in.v.y); x[4] = bf_hi(in.v.y); x[5] = bf_lo(in.v.z); x[6] = bf_hi(in.v.z); x[7] = bf_lo(in.v.w); x[8] = bf_hi(in.v.w);
#pragma unroll
    for (int i = 0; i < 8; ++i) o[i] = w0 * x[i] + w1 * x[i + 1] + w2 * x[i + 2] + bias;
}
__device__ __forceinline__ void conv8(const bf16_t* __restrict__ row, int b, int s0, float w0, float w1, float w2, float bias, float (&o)[8]) {
    const Conv8In in = conv8_load(row, b, s0); conv8_apply(in, w0, w1, w2, bias, o);
}

__device__ __forceinline__ void hyena_item(const Params& p, LAS unsigned char* lds, int l, int c) {
    const int tid = otid();
    LAS c2* X = (LAS c2*)lds;
    const c2* tw = (const c2*)(p.ws + WS_TW);
    const bf16_t* HY = (const bf16_t*)(p.ws + WS_VHT) + (size_t)512 * T;
    const bf16_t* r_x0 = HY + (size_t)c * T; const bf16_t* r_x1 = HY + (size_t)(512 + c) * T; const bf16_t* r_vv = HY + (size_t)(1024 + c) * T;
    const float* cw = p.in[7] + (size_t)l * 3 * 1536; const float* cb = p.in[8] + (size_t)l * 1536;
    const float x0w0 = cw[c], x0w1 = cw[1536 + c], x0w2 = cw[3072 + c], x0b = cb[c];
    const float x1w0 = cw[512 + c], x1w1 = cw[1536 + 512 + c], x1w2 = cw[3072 + 512 + c], x1b = cb[512 + c];
    const float vw0 = cw[1024 + c], vw1 = cw[1536 + 1024 + c], vw2 = cw[3072 + 1024 + c], vb = cb[1024 + c];
    LAS c2* TWL = (LAS c2*)(lds + 131072 + 1024);
    if (tid < 256) TWL[tid] = tw[tid < 128 ? tid * 128 : tid - 128];
#pragma unroll
    for (int it = 0; it < 2; ++it) {
        const int s0 = (tid + 512 * it) * 8;
        float a0[8], a1[8], v0[8], v1[8];
        conv8(r_x1, 0, s0, x1w0, x1w1, x1w2, x1b, a0); conv8(r_x1, 1, s0, x1w0, x1w1, x1w2, x1b, a1);
        conv8(r_vv, 0, s0, vw0, vw1, vw2, vb, v0); conv8(r_vv, 1, s0, vw0, vw1, vw2, vb, v1);
#pragma unroll
        for (int i = 0; i < 8; ++i) X[sw(s0 + i)] = mk2(a0[i] * v0[i], a1[i] * v1[i]);
    }
    __syncthreads();
    const c2* HF = (const c2*)(p.ws + WS_HF) + (size_t)c * NFFT;
    c2 hfr[32];
#pragma unroll
    for (int i = 0; i < 8; ++i) { const f32x4 h01 = *(const f32x4*)(HF + 4 * (tid + 512 * i)), h23 = *(const f32x4*)(HF + 4 * (tid + 512 * i) + 2);
        hfr[4 * i + 0] = mk2(h01[0], h01[1]); hfr[4 * i + 1] = mk2(h01[2], h01[3]); hfr[4 * i + 2] = mk2(h23[0], h23[1]); hfr[4 * i + 3] = mk2(h23[2], h23[3]); }
    fft_fwd<true, true>(X, TWL);
#pragma unroll
    for (int i = 0; i < 8; ++i) {
        const int b4 = 4 * (tid + 512 * i);
        const int i0 = sw(b4), i1 = sw(b4 + 1), i2 = sw(b4 + 2), i3 = sw(b4 + 3);
        const c2 a0 = X[i0], a1 = X[i1], a2 = X[i2], a3 = X[i3];
        c2 b0 = cadd(a0, a2), b1 = csub(a0, a2), b2 = cadd(a1, a3), d = csub(a1, a3);
        c2 b3 = mk2(d.y, -d.x);
        const c2 y0 = cmul(cadd(b0, b2), hfr[4 * i + 0]), y1 = cmul(cadd(b1, b3), hfr[4 * i + 1]), y2 = cmul(csub(b0, b2), hfr[4 * i + 2]), y3 = cmul(csub(b1, b3), hfr[4 * i + 3]);
        b0 = cadd(y0, y2); b1 = csub(y0, y2); b2 = cadd(y1, y3); d = csub(y1, y3);
        b3 = mk2(-d.y, d.x);
        X[i0] = cadd(b0, b2); X[i1] = cadd(b1, b3); X[i2] = csub(b0, b2); X[i3] = csub(b1, b3);
    }
    __syncthreads();
    Conv8In xin[2][2];
#pragma unroll
    for (int it = 0; it < 2; ++it) { xin[it][0] = conv8_load(r_x0, 0, (tid + 512 * it) * 8); xin[it][1] = conv8_load(r_x0, 1, (tid + 512 * it) * 8); }
    fft_inv<true, true>(X, TWL);
    bf16_t* BT = (bf16_t*)(p.ws + WS_BOUTT) + (size_t)c * T;
#pragma unroll
    for (int it = 0; it < 2; ++it) {
        const int s0 = (tid + 512 * it) * 8;
        float g0[8], g1[8];
        conv8_apply(xin[it][0], x0w0, x0w1, x0w2, x0b, g0); conv8_apply(xin[it][1], x0w0, x0w1, x0w2, x0b, g1);
        float y0[8], y1[8];
#pragma unroll
        for (int i = 0; i < 8; ++i) { const c2 y = X[sw(s0 + i)]; y0[i] = y.x * g0[i]; y1[i] = y.y * g1[i]; }
        u32x4 w0, w1;
        w0.x = cvt_pk_bf16(y0[0], y0[1]); w0.y = cvt_pk_bf16(y0[2], y0[3]); w0.z = cvt_pk_bf16(y0[4], y0[5]); w0.w = cvt_pk_bf16(y0[6], y0[7]);
        w1.x = cvt_pk_bf16(y1[0], y1[1]); w1.y = cvt_pk_bf16(y1[2], y1[3]); w1.z = cvt_pk_bf16(y1[4], y1[5]); w1.w = cvt_pk_bf16(y1[6], y1[7]);
        *(u32x4*)(BT + s0) = w0; *(u32x4*)(BT + SEQ + s0) = w1;
    }
    __syncthreads();
}

__device__ __forceinline__ void bout_panel_transpose(const Params& p, LAS unsigned char* lds, int pm) {
    const int tid = otid(), lane = tid & 63, wv = tid >> 6;
    const bf16_t* BT = (const bf16_t*)(p.ws + WS_BOUTT);
    bf16_t* BO = (bf16_t*)(p.ws + WS_BOUT);
    LAS unsigned short* tile = (LAS unsigned short*)(lds + wv * 8704);
    for (int tl = wv; tl < 32; tl += 8) {
        const int t0 = pm * 256 + (tl & 3) * 64, c0 = (tl >> 2) * 64;
        const bf16_t* src = BT + (size_t)(c0 + lane) * T + t0;
        u32x4 v[8];
#pragma unroll
        for (int k = 0; k < 8; ++k) v[k] = *(const u32x4*)(src + k * 8);
#pragma unroll
        for (int k = 0; k < 8; ++k)
#pragma unroll
            for (int j = 0; j < 4; ++j) *(LAS unsigned*)(tile + lane * 66 + k * 8 + 2 * j) = v[k][j];
        __builtin_amdgcn_wave_barrier();
        bf16_t* dst = BO + (size_t)(t0 + lane) * 512 + c0;
#pragma unroll
        for (int c8 = 0; c8 < 8; ++c8) {
            u32x4 w;
#pragma unroll
            for (int j = 0; j < 4; ++j) { const unsigned lo = tile[(c8 * 8 + 2 * j) * 66 + lane], hi = tile[(c8 * 8 + 2 * j + 1) * 66 + lane]; w[j] = lo | (hi << 16); }
            *(u32x4*)(dst + c8 * 8) = w;
        }
        __builtin_amdgcn_wave_barrier();
    }
}

__device__ __forceinline__ void norm_frag(const u32x4 r0, const u32x4 r1, const float (&gw)[16], bf16x8& f0, bf16x8& f1) {
    float v[16];
    v[0] = bf_lo(r0.x); v[1] = bf_hi(r0.x); v[2] = bf_lo(r0.y); v[3] = bf_hi(r0.y); v[4] = bf_lo(r0.z); v[5] = bf_hi(r0.z); v[6] = bf_lo(r0.w); v[7] = bf_hi(r0.w);
    v[8] = bf_lo(r1.x); v[9] = bf_hi(r1.x); v[10] = bf_lo(r1.y); v[11] = bf_hi(r1.y); v[12] = bf_lo(r1.z); v[13] = bf_hi(r1.z); v[14] = bf_lo(r1.w); v[15] = bf_hi(r1.w);
    float ss = 0.f;
#pragma unroll
    for (int i = 0; i < 16; ++i) ss += v[i] * v[i];
    ss += __shfl_xor(ss, 16); ss += __shfl_xor(ss, 32);
    const float rs = rsqrtf(ss * (1.f / 64.f) + 1e-6f);
#pragma unroll
    for (int i = 0; i < 16; ++i) v[i] *= rs * gw[i];
    u32x4 a, b;
    a.x = cvt_pk_bf16(v[0], v[1]); a.y = cvt_pk_bf16(v[2], v[3]); a.z = cvt_pk_bf16(v[4], v[5]); a.w = cvt_pk_bf16(v[6], v[7]);
    b.x = cvt_pk_bf16(v[8], v[9]); b.y = cvt_pk_bf16(v[10], v[11]); b.z = cvt_pk_bf16(v[12], v[13]); b.w = cvt_pk_bf16(v[14], v[15]);
    f0 = __builtin_bit_cast(bf16x8, a); f1 = __builtin_bit_cast(bf16x8, b);
}

__device__ __forceinline__ void na_task(const Params& p, LAS float* rpb_l, int l, int task) {
    const int lane = otid() & 63, n = lane & 15, g = lane >> 4;
    const int h = task & 7, r = (task >> 3) & 127, b = task >> 10;
    int r0 = r - 4; r0 = r0 < 0 ? 0 : (r0 > 120 ? 120 : r0);
    const float* rp = p.in[6] + (size_t)(l * 8 + h) * 465;
    for (int i = lane; i < 465; i += 64) rpb_l[i] = rp[i];
    float gq[16];
#pragma unroll
    for (int ks = 0; ks < 2; ++ks)
#pragma unroll
        for (int e = 0; e < 8; ++e) gq[ks * 8 + e] = p.in[4][l * 64 + ks * 32 + g * 8 + e] * p.in[5][l * 64 + ks * 32 + g * 8 + e] * 0.125f;
    const bf16_t* QK = (const bf16_t*)(p.ws + WS_QK);
    const bf16_t* VT = (const bf16_t*)(p.ws + WS_VHT);
    bf16_t* AO = (bf16_t*)(p.ws + WS_AOUT);
    const size_t tokrow = (size_t)b * SEQ + (size_t)r * 64;
    __builtin_amdgcn_wave_barrier();
#pragma unroll 1
    for (int qt = 0; qt < 4; ++qt) {
        bf16x8 qf0, qf1;
        { const bf16_t* qp = QK + (tokrow + qt * 16 + n) * 1024 + h * 64 + g * 8;
          norm_frag(*(const u32x4*)qp, *(const u32x4*)(qp + 32), gq, qf0, qf1); }
        const int kc0 = (qt == 0) ? 0 : (qt == 1 ? 8 : (qt == 2 ? 24 : 32));
        f32x4 st[8][2];
#pragma unroll
        for (int jh = 0; jh < 2; ++jh) {
            u32x4 kr[4][2][2];
#pragma unroll
            for (int jj = 0; jj < 4; ++jj)
#pragma unroll
                for (int ct = 0; ct < 2; ++ct) {
                    const bf16_t* kp = QK + ((size_t)b * SEQ + (size_t)(r0 + jh * 4 + jj) * 64 + kc0 + ct * 16 + n) * 1024 + 512 + h * 64 + g * 8;
                    kr[jj][ct][0] = *(const u32x4*)kp; kr[jj][ct][1] = *(const u32x4*)(kp + 32);
                }
            __builtin_amdgcn_sched_barrier(0);
#pragma unroll
            for (int jj = 0; jj < 4; ++jj)
#pragma unroll
                for (int ct = 0; ct < 2; ++ct) {
                    const bf16x8 kf0 = __builtin_bit_cast(bf16x8, kr[jj][ct][0]), kf1 = __builtin_bit_cast(bf16x8, kr[jj][ct][1]);
                    f32x4 a = (f32x4){0.f, 0.f, 0.f, 0.f}, d = (f32x4){0.f, 0.f, 0.f, 0.f};
                    a = __builtin_amdgcn_mfma_f32_16x16x32_bf16(kf0, qf0, a, 0, 0, 0);
                    a = __builtin_amdgcn_mfma_f32_16x16x32_bf16(kf1, qf1, a, 0, 0, 0);
                    d = __builtin_amdgcn_mfma_f32_16x16x32_bf16(kf0, kf0, d, 0, 0, 0);
                    d = __builtin_amdgcn_mfma_f32_16x16x32_bf16(kf1, kf1, d, 0, 0, 0);
                    const int n3 = n & 3;
                    const float dsel = (n3 == 0) ? d[0] : (n3 == 1 ? d[1] : (n3 == 2 ? d[2] : d[3]));
                    const float rkl = rsqrtf(dsel * (1.f / 64.f) + 1e-6f);
                    f32x4 rk4;
#pragma unroll
                    for (int i = 0; i < 4; ++i) rk4[i] = __shfl(rkl, 20 * g + i);
                    st[jh * 4 + jj][ct] = a * rk4;
                }
        }
        const int cq = qt * 16 + n; int c0 = cq - 8; c0 = c0 < 0 ? 0 : (c0 > 48 ? 48 : c0);
        float mx = -INFINITY;
#pragma unroll
        for (int j = 0; j < 8; ++j) { const int dr = r0 + j - r + 7;
#pragma unroll
            for (int ct = 0; ct < 2; ++ct)
#pragma unroll
                for (int i = 0; i < 4; ++i) { const int ck = kc0 + ct * 16 + g * 4 + i; const bool valid = (ck >= c0) && (ck < c0 + 16);
                    int dc = ck - cq + 15; dc = dc < 0 ? 0 : (dc > 30 ? 30 : dc);
                    float v = st[j][ct][i] + rpb_l[dr * 31 + dc]; v = valid ? v : -INFINITY; st[j][ct][i] = v; mx = fmaxf(mx, v); } }
        mx = fmaxf(mx, __shfl_xor(mx, 16)); mx = fmaxf(mx, __shfl_xor(mx, 32));
        float sum = 0.f;
#pragma unroll
        for (int j = 0; j < 8; ++j)
#pragma unroll
            for (int ct = 0; ct < 2; ++ct)
#pragma unroll
                for (int i = 0; i < 4; ++i) { const float e = __expf(st[j][ct][i] - mx); st[j][ct][i] = e; sum += e; }
        sum += __shfl_xor(sum, 16); sum += __shfl_xor(sum, 32);
        f32x4 o[4];
#pragma unroll
        for (int nd = 0; nd < 4; ++nd) o[nd] = (f32x4){0.f, 0.f, 0.f, 0.f};
#pragma unroll
        for (int jp = 0; jp < 4; ++jp) {
            u32x2 vr[2][4][2];
#pragma unroll
            for (int jj = 0; jj < 2; ++jj) {
                const size_t tk0 = (size_t)b * SEQ + (size_t)(r0 + jp * 2 + jj) * 64 + kc0 + g * 4;
#pragma unroll
                for (int nd = 0; nd < 4; ++nd) { const bf16_t* vp = VT + (size_t)(h * 64 + nd * 16 + n) * T + tk0; vr[jj][nd][0] = *(const u32x2*)vp; vr[jj][nd][1] = *(const u32x2*)(vp + 16); }
            }
            __builtin_amdgcn_sched_barrier(0);
#pragma unroll
            for (int jj = 0; jj < 2; ++jj) {
                const int j = jp * 2 + jj;
                u32x4 pw; pw.x = cvt_pk_bf16(st[j][0][0], st[j][0][1]); pw.y = cvt_pk_bf16(st[j][0][2], st[j][0][3]); pw.z = cvt_pk_bf16(st[j][1][0], st[j][1][1]); pw.w = cvt_pk_bf16(st[j][1][2], st[j][1][3]);
                const bf16x8 pf = __builtin_bit_cast(bf16x8, pw);
#pragma unroll
                for (int nd = 0; nd < 4; ++nd) {
                    u32x4 vw; vw.x = vr[jj][nd][0].x; vw.y = vr[jj][nd][0].y; vw.z = vr[jj][nd][1].x; vw.w = vr[jj][nd][1].y;
                    o[nd] = __builtin_amdgcn_mfma_f32_16x16x32_bf16(__builtin_bit_cast(bf16x8, vw), pf, o[nd], 0, 0, 0);
                }
            }
        }
        const float inv = 1.f / sum;
#pragma unroll
        for (int nd = 0; nd < 4; ++nd) { u32x2 w; w.x = cvt_pk_bf16(o[nd][0] * inv, o[nd][1] * inv); w.y = cvt_pk_bf16(o[nd][2] * inv, o[nd][3] * inv);
            *(u32x2*)(AO + (tokrow + qt * 16 + n) * 512 + h * 64 + nd * 16 + g * 4) = w; }
    }
}

__device__ __forceinline__ void cas_desc(unsigned& a, unsigned& b) { const unsigned mx = a > b ? a : b, mn = a > b ? b : a; a = mx; b = mn; }
__device__ __forceinline__ void sort16_desc(unsigned (&v)[16]) {
#pragma unroll
    for (int k = 2; k <= 16; k <<= 1)
#pragma unroll
        for (int j = k >> 1; j > 0; j >>= 1)
#pragma unroll
            for (int i = 0; i < 16; ++i) { const int l = i ^ j; if (l > i) { if ((i & k) == 0) cas_desc(v[i], v[l]); else cas_desc(v[l], v[i]); } }
}
__device__ __forceinline__ void merge16_desc(unsigned (&v)[16]) {
#pragma unroll
    for (int j = 8; j > 0; j >>= 1)
#pragma unroll
        for (int i = 0; i < 16; ++i) { const int l = i ^ j; if (l > i) cas_desc(v[i], v[l]); }
}

__device__ __forceinline__ void topk_task(const Params& p, LAS float* sc, int l, int task) {
    const int lane = otid() & 63, n = lane & 15, g = lane >> 4;
    const int list = task & 15, tokblk = task >> 4;
    const bf16_t* QP = (const bf16_t*)(p.ws + WS_QPEER);
    const bf16_t* SK = (const bf16_t*)(p.ws + WS_SK) + ((size_t)l * 16 + list) * 128 * 128;
    bf16x8 qf[2][4];
#pragma unroll
    for (int tt = 0; tt < 2; ++tt)
#pragma unroll
        for (int ks = 0; ks < 4; ++ks) qf[tt][ks] = *(const bf16x8*)(QP + (size_t)(tokblk * 32 + tt * 16 + n) * 2048 + list * 128 + ks * 32 + g * 8);
#pragma unroll 2
    for (int kt = 0; kt < 8; ++kt) {
        bf16x8 kf[4];
#pragma unroll
        for (int ks = 0; ks < 4; ++ks) kf[ks] = *(const bf16x8*)(SK + (size_t)(kt * 16 + n) * 128 + ks * 32 + g * 8);
#pragma unroll
        for (int tt = 0; tt < 2; ++tt) {
            f32x4 a = (f32x4){0.f, 0.f, 0.f, 0.f};
#pragma unroll
            for (int ks = 0; ks < 4; ++ks) a = __builtin_amdgcn_mfma_f32_16x16x32_bf16(kf[ks], qf[tt][ks], a, 0, 0, 0);
            *(LAS f32x4*)(sc + (tt * 16 + n) * 136 + kt * 16 + g * 4) = a;
        }
    }
    __builtin_amdgcn_wave_barrier();
    const int row = lane >> 1, half = lane & 1;
    unsigned best[16];
#pragma unroll
    for (int grp = 0; grp < 4; ++grp) {
        unsigned v[16];
#pragma unroll
        for (int i = 0; i < 4; ++i) { const int chunk = 2 * (grp * 4 + i) + half;
            const f32x4 s4 = *(const LAS f32x4*)(sc + row * 136 + chunk * 4);
#pragma unroll
            for (int e = 0; e < 4; ++e) v[i * 4 + e] = (fmap(s4[e]) & ~0x7Fu) | (unsigned)(127 - (chunk * 4 + e)); }
        sort16_desc(v);
        if (grp == 0) {
#pragma unroll
            for (int i = 0; i < 16; ++i) best[i] = v[i];
        } else {
#pragma unroll
            for (int i = 0; i < 16; ++i) best[i] = best[i] > v[15 - i] ? best[i] : v[15 - i];
            merge16_desc(best);
        }
    }
    {
        unsigned oth[16];
#pragma unroll
        for (int i = 0; i < 16; ++i) oth[i] = (unsigned)__shfl_xor((int)best[i], 1);
#pragma unroll
        for (int i = 0; i < 16; ++i) best[i] = best[i] > oth[15 - i] ? best[i] : oth[15 - i];
        merge16_desc(best);
    }
    __builtin_amdgcn_wave_barrier();
    unsigned* TK = (unsigned*)(p.ws + WS_TOPK) + ((size_t)(tokblk * 32 + row) * 16 + list) * 16 + half * 8;
    u32x4 w0, w1;
    if (half == 0) { w0.x = best[0]; w0.y = best[1]; w0.z = best[2]; w0.w = best[3]; w1.x = best[4]; w1.y = best[5]; w1.z = best[6]; w1.w = best[7]; }
    else { w0.x = best[8]; w0.y = best[9]; w0.z = best[10]; w0.w = best[11]; w1.x = best[12]; w1.y = best[13]; w1.z = best[14]; w1.w = best[15]; }
    *(u32x4*)TK = w0; *(u32x4*)(TK + 4) = w1;
}

__device__ __forceinline__ float gelu_tanh(float x) { const float u = 0.7978845608028654f * (x + 0.044715f * x * x * x); return 0.5f * x * (1.f + tanhf(u)); }

__device__ __forceinline__ void peer_token(const Params& p, LAS unsigned char* xh, int l, int tok, const unsigned char* cand_tab) {
    const int lane = otid() & 63, n = lane & 15, g = lane >> 4;
    const float* XM = (const float*)(p.ws + WS_XMID) + (size_t)tok * 1024;
    const float* g2 = p.in[19] + l * 1024;
    const unsigned* TK = (const unsigned*)(p.ws + WS_TOPK) + (size_t)tok * 256;
    const int ci = cand_tab[lane] >> 4, cj = cand_tab[lane] & 15;
    LAS unsigned* tkl = (LAS unsigned*)(xh + 1024);
    *(LAS u32x4*)(tkl + lane * 4) = *(const u32x4*)(TK + lane * 4);
    float xm[16];
#pragma unroll
    for (int i = 0; i < 4; ++i) { const f32x4 a = *(const f32x4*)(XM + lane * 16 + i * 4); xm[i * 4 + 0] = a[0]; xm[i * 4 + 1] = a[1]; xm[i * 4 + 2] = a[2]; xm[i * 4 + 3] = a[3]; }
    float ss = 0.f;
#pragma unroll
    for (int i = 0; i < 16; ++i) ss += xm[i] * xm[i];
    ss = wave_sum(ss);
    const float rstd = rsqrtf(ss * (1.f / 1024.f) + 1e-6f);
    {
        float xs[16];
#pragma unroll
        for (int i = 0; i < 4; ++i) { const f32x4 ga = *(const f32x4*)(g2 + lane * 16 + i * 4);
            const float r2 = 2.f * rstd; xs[i * 4 + 0] = xm[i * 4 + 0] * r2 * ga[0]; xs[i * 4 + 1] = xm[i * 4 + 1] * r2 * ga[1]; xs[i * 4 + 2] = xm[i * 4 + 2] * r2 * ga[2]; xs[i * 4 + 3] = xm[i * 4 + 3] * r2 * ga[3]; }
        u32x2 w; w.x = pack8_fp4(xs[0], xs[1], xs[2], xs[3], xs[4], xs[5], xs[6], xs[7]); w.y = pack8_fp4(xs[8], xs[9], xs[10], xs[11], xs[12], xs[13], xs[14], xs[15]);
        *(LAS u32x2*)(xh + lane * 8) = w;
    }
    __builtin_amdgcn_wave_barrier();
    float out[16];
#pragma unroll
    for (int i = 0; i < 16; ++i) out[i] = 0.f;
    const unsigned char* UT = p.ws + WS_UT + (size_t)l * 16384 * 512;
    const unsigned char* VT = p.ws + WS_VT + (size_t)l * 16384 * 512;
    const bool cvalid = lane < 50;
#pragma unroll 1
    for (int h = 0; h < 8; ++h) {
        const unsigned ka = tkl[32 * h + ci], kb = tkl[32 * h + 16 + cj];
        const float cand = funmap(ka & ~0x7Fu) + funmap(kb & ~0x7Fu);
        const int eid_src = (127 - (int)(ka & 0x7Fu)) * 128 + (127 - (int)(kb & 0x7Fu));
        unsigned ck = cvalid ? ((fmap(cand) & ~0xFFu) | (unsigned)lane) : 0u;
        int rank = 0;
#pragma unroll
        for (int m = 0; m < 50; ++m) rank += ((unsigned)__builtin_amdgcn_readlane((int)ck, m) > ck) ? 1 : 0;
        const int eid = __builtin_amdgcn_ds_permute(rank * 4, eid_src);
        const float fs = __int_as_float(__builtin_amdgcn_ds_permute(rank * 4, __float_as_int(cand))) * rstd;
        const float m0 = __int_as_float(__builtin_amdgcn_readlane(__float_as_int(fs), 0));
        const float ex = (lane < 16) ? __expf(fs - m0) : 0.f;
        const float gsm = ex / wave_sum(ex);
        const int eid_n = __shfl(eid, n);
        u32x4 uu[8]; u32x2 vv[16];
        const unsigned char* up = UT + (size_t)eid_n * 512 + g * 16;
#pragma unroll
        for (int i = 0; i < 8; ++i) uu[i] = *(const u32x4*)(up + i * 64);
#pragma unroll
        for (int k = 0; k < 16; ++k) { const int ek = __builtin_amdgcn_readlane(eid, k); vv[k] = *(const u32x2*)(VT + (size_t)ek * 512 + lane * 8); }
        f32x4 acc = (f32x4){0.f, 0.f, 0.f, 0.f};
        __builtin_amdgcn_sched_barrier(0);
#pragma unroll
        for (int i = 0; i < 8; ++i) {
            const u32x4 x0 = *(const LAS u32x4*)(xh + i * 64 + g * 16);
            v8i_t av, bv;
            av[0] = (int)x0.x; av[1] = (int)x0.y; av[2] = (int)x0.z; av[3] = (int)x0.w;
            bv[0] = (int)uu[i].x; bv[1] = (int)uu[i].y; bv[2] = (int)uu[i].z; bv[3] = (int)uu[i].w;
            acc = __builtin_amdgcn_mfma_scale_f32_16x16x128_f8f6f4(av, bv, acc, 4  , 4  , 0, 127, 0, 127);
            __builtin_amdgcn_sched_barrier(0);
        }
        const float wgt = gsm * gelu_tanh(acc[0] * (1.f / 128.f)) * (1.f / 64.f);
#pragma unroll
        for (int k = 0; k < 16; ++k) {
            const float wk = __int_as_float(__builtin_amdgcn_readlane(__float_as_int(wgt), k));
#ifdef DIAG_VF32
            { const int ek2 = __builtin_amdgcn_readfirstlane(__shfl(eid, k)); const float* vf = p.in[23] + ((size_t)l * 16384 + ek2) * 1024 + lane * 16;
#pragma unroll
              for (int j = 0; j < 16; ++j) out[j] += wk * 64.f * vf[j]; }
            if (false)
#endif
#pragma unroll
            for (int q = 0; q < 2; ++q)
            {
                const f32x2 f0 = __builtin_amdgcn_cvt_scalef32_pk_f32_fp4(vv[k][q], 1.0f, 0), f1 = __builtin_amdgcn_cvt_scalef32_pk_f32_fp4(vv[k][q], 1.0f, 1);
                const f32x2 f2 = __builtin_amdgcn_cvt_scalef32_pk_f32_fp4(vv[k][q], 1.0f, 2), f3 = __builtin_amdgcn_cvt_scalef32_pk_f32_fp4(vv[k][q], 1.0f, 3);
                out[q * 8 + 0] += wk * f0.x; out[q * 8 + 1] += wk * f0.y; out[q * 8 + 2] += wk * f1.x; out[q * 8 + 3] += wk * f1.y;
                out[q * 8 + 4] += wk * f2.x; out[q * 8 + 5] += wk * f2.y; out[q * 8 + 6] += wk * f3.x; out[q * 8 + 7] += wk * f3.y;
            }
        }
    }
    float ss2 = 0.f;
#pragma unroll
    for (int i = 0; i < 16; ++i) { out[i] += xm[i]; ss2 += out[i] * out[i]; }
    float* XO = p.out + (size_t)tok * 1024 + lane * 16;
#pragma unroll
    for (int i = 0; i < 4; ++i) *(f32x4*)(XO + i * 4) = (f32x4){out[i * 4 + 0], out[i * 4 + 1], out[i * 4 + 2], out[i * 4 + 3]};
    if (l < DEPTH - 1) {
        ss2 = wave_sum(ss2);
        const float rs = rsqrtf(ss2 * (1.f / 1024.f) + 1e-6f);
        bf16_t* xb = (bf16_t*)(p.ws + WS_XB) + (size_t)tok * 1024 + lane * 16;
#pragma unroll
        for (int i = 0; i < 2; ++i) { u32x4 w; w.x = cvt_pk_bf16(out[i * 8 + 0] * rs, out[i * 8 + 1] * rs); w.y = cvt_pk_bf16(out[i * 8 + 2] * rs, out[i * 8 + 3] * rs);
            w.z = cvt_pk_bf16(out[i * 8 + 4] * rs, out[i * 8 + 5] * rs); w.w = cvt_pk_bf16(out[i * 8 + 6] * rs, out[i * 8 + 7] * rs);
            *(u32x4*)(xb + i * 8) = w; }
    }
    __builtin_amdgcn_wave_barrier();
}

#ifdef DIAG
constexpr size_t WS_DIAG = WS_END;
__device__ __forceinline__ unsigned hsh(unsigned a) { a ^= a >> 16; a *= 0x7feb352du; a ^= a >> 15; a *= 0x846ca68bu; a ^= a >> 16; return a; }
__device__ __forceinline__ float bfr(float f) { return bf_lo(cvt_pk_bf16(f, 0.f) & 0xffffu); }
__device__ __forceinline__ void report(float* dg, int k, float a, float e, float fl) { const float r = fabsf(a - e) / (fabsf(e) + fl); atomicMax((unsigned*)dg + k, __float_as_uint(r != r ? 1e30f : r)); }
__device__ __forceinline__ float conv1(const bf16_t* row, int b, int s, float w0, float w1, float w2, float bias) {
    const bf16_t* rp = row + (size_t)b * SEQ;
    const float xm = s > 0 ? bf1(rp[s - 1]) : 0.f, x0 = bf1(rp[s]), xp = s < SEQ - 1 ? bf1(rp[s + 1]) : 0.f;
    return w0 * xm + w1 * x0 + w2 * xp + bias;
}
__device__ __forceinline__ void diag_checks(const Params& p) {
    const int tid = otid(); unsigned char* ws = p.ws; float* dg = (float*)(ws + WS_DIAG);
    const int chk = blockIdx.x; const int l = 0;
    const bf16_t* XB = (const bf16_t*)(ws + WS_XB);
    if (chk == 0 && tid < 256) {
        const unsigned hh = hsh(tid * 7 + 1); const int n = hh % 3072, k = (hh >> 12) % 1024; const int sc = n < 1024 ? n : n + 2048;
        report(dg, 0, bf1(((const bf16_t*)(ws + WS_WTA))[(size_t)n * 1024 + k]), bfr(p.in[2][(size_t)k * 5120 + sc] * p.in[1][k]), 1e-3f);
        const int n2 = hh % 2048; report(dg, 0, bf1(((const bf16_t*)(ws + WS_WQ))[(size_t)n2 * 1024 + k]), bfr(p.in[20][(size_t)k * 2048 + n2] * p.in[19][k]), 1e-3f);
        const int n3 = hh % 1024, k3 = (hh >> 12) % 512; report(dg, 0, bf1(((const bf16_t*)(ws + WS_WHY))[(size_t)n3 * 512 + k3]), bfr(p.in[17][(size_t)k3 * 1024 + n3]), 1e-3f);
        const int n4 = hh % 2048; const int sc4 = n4 + 1024; report(dg, 0, bf1(((const bf16_t*)(ws + WS_WTB))[(size_t)n4 * 1024 + k]), bfr(p.in[2][(size_t)k * 5120 + sc4] * p.in[1][k]), 1e-3f);
    }
    if (chk == 3 && tid < 256) {
        const unsigned hh = hsh(tid * 13 + 5); const int tok = hh % T, h = (hh >> 16) % 8, d = (hh >> 20) % 64;
        const bf16_t* QK = (const bf16_t*)(ws + WS_QK); const bf16_t* VT = (const bf16_t*)(ws + WS_VHT);
        const int b = tok / SEQ, s = tok % SEQ, r = s / 64, cq = s % 64;
        int r0 = r - 4; r0 = r0 < 0 ? 0 : (r0 > 120 ? 120 : r0); int c0 = cq - 8; c0 = c0 < 0 ? 0 : (c0 > 48 ? 48 : c0);
        float sq = 0.f; for (int i = 0; i < 64; ++i) { const float v = bf1(QK[(size_t)tok * 1024 + h * 64 + i]); sq += v * v; }
        const float rq = rsqrtf(sq / 64.f + 1e-6f);
        float mx = -INFINITY, sum = 0.f, o = 0.f;
        for (int pass = 0; pass < 2; ++pass)
            for (int j = 0; j < 8; ++j) for (int cc = 0; cc < 16; ++cc) {
                const int kt = b * SEQ + (r0 + j) * 64 + c0 + cc; float sk = 0.f, dot = 0.f;
                for (int i = 0; i < 64; ++i) { const float kv = bf1(QK[(size_t)kt * 1024 + 512 + h * 64 + i]); sk += kv * kv; dot += kv * p.in[5][l * 64 + i] * bf1(QK[(size_t)tok * 1024 + h * 64 + i]) * p.in[4][l * 64 + i]; }
                int dc = (c0 + cc) - cq + 15; dc = dc < 0 ? 0 : (dc > 30 ? 30 : dc);
                const float sc = dot * rq * rsqrtf(sk / 64.f + 1e-6f) * 0.125f + p.in[6][(size_t)((l * 8 + h) * 15 + (r0 + j - r + 7)) * 31 + dc];
                if (pass == 0) mx = fmaxf(mx, sc); else { const float e = expf(sc - mx); sum += e; o += e * bf1(VT[(size_t)(h * 64 + d) * T + kt]); }
            }
        report(dg, 3, bf1(((const bf16_t*)(ws + WS_AOUT))[(size_t)tok * 512 + h * 64 + d]), o / sum, 0.02f);
    }
    if (chk == 4 && tid < 64) {
        const unsigned hh = hsh(tid * 17 + 3); const int b = hh & 1, t = (hh >> 1) % SEQ, c = (hh >> 16) % 512;
        const bf16_t* HY = (const bf16_t*)(ws + WS_VHT) + (size_t)512 * T;
        const float* cw = p.in[7] + (size_t)l * 3 * 1536; const float* cb = p.in[8] + (size_t)l * 1536;
        const float* H2 = (const float*)(ws + WS_H2) + (size_t)l * SEQ * 64; const float* w3 = p.in[14] + (size_t)l * 64 * 1024;
        const float ad = fabsf(-3.0701134573253945f + (-15.350567286626972f + 3.0701134573253945f) * ((float)c / 511.f));
        float y = 0.f;
        for (int s = 0; s < SEQ; ++s) {
            const float z = conv1(HY + (size_t)(1024 + c) * T, b, s, cw[1024 + c], cw[1536 + 1024 + c], cw[3072 + 1024 + c], cb[1024 + c]) * conv1(HY + (size_t)(512 + c) * T, b, s, cw[512 + c], cw[1536 + 512 + c], cw[3072 + 512 + c], cb[512 + c]);
            const int dlt = t - s, ad_ = dlt < 0 ? -dlt : dlt; float hv = 0.f;
            const float dec = expf(-(float)ad_ * (1.f / 8191.f) * ad);
            if (dlt >= 0) { float a = 0.f; for (int j = 0; j < 64; ++j) a += H2[(size_t)ad_ * 64 + j] * w3[j * 1024 + c]; hv += a * dec; }
            if (dlt <= 0) { float a = 0.f; for (int j = 0; j < 64; ++j) a += H2[(size_t)ad_ * 64 + j] * w3[j * 1024 + 512 + c]; hv += a * dec; }
            if (dlt == 0) hv += p.in[15][l * 512 + c];
            y += z * hv;
        }
        y *= conv1(HY + (size_t)c * T, b, t, cw[c], cw[1536 + c], cw[3072 + c], cb[c]);
        report(dg, 4, bf1(((const bf16_t*)(ws + WS_BOUT))[(size_t)(b * SEQ + t) * 512 + c]), y, 0.05f);
    }
    if (chk == 5 && tid < 256) {
        const unsigned hh = hsh(tid * 19 + 7); const int row = hh % T, col = (hh >> 16) % 1024;
        float d0 = 0.f, d1 = 0.f;
        for (int k = 0; k < 512; ++k) { d0 += bf1(((const bf16_t*)(ws + WS_AOUT))[(size_t)row * 512 + k]) * bf1(((const bf16_t*)(ws + WS_WNA))[(size_t)col * 512 + k]);
            d1 += bf1(((const bf16_t*)(ws + WS_BOUT))[(size_t)row * 512 + k]) * bf1(((const bf16_t*)(ws + WS_WHY))[(size_t)col * 512 + k]); }
        const bf16_t* GT = (const bf16_t*)(ws + WS_GATE);
        report(dg, 5, bf1(((const bf16_t*)(ws + WS_MERGED))[(size_t)row * 1024 + col]), bf1(GT[(size_t)row * 2048 + col]) * d0 + bf1(GT[(size_t)row * 2048 + 1024 + col]) * d1, 0.02f);
    }
    if (chk == 6 && tid < 256) {
        const unsigned hh = hsh(tid * 23 + 9); const int row = hh % T, col = (hh >> 16) % 1024;
        float d0 = 0.f; for (int k = 0; k < 1024; ++k) d0 += bf1(((const bf16_t*)(ws + WS_MERGED))[(size_t)row * 1024 + k]) * bf1(((const bf16_t*)(ws + WS_WOUT))[(size_t)col * 1024 + k]);
        report(dg, 6, ((const float*)(ws + WS_XMID))[(size_t)row * 1024 + col], p.in[0][(size_t)row * 1024 + col] + d0, 0.02f);
        report(dg, 6, bf1(((const bf16_t*)(ws + WS_XBMID))[(size_t)row * 1024 + col]), p.in[0][(size_t)row * 1024 + col] + d0, 0.02f);
    }
    if (chk == 7 && tid < 256) {
        const unsigned hh = hsh(tid * 29 + 11); const int row = hh % T, col = (hh >> 16) % 2048;
        float d0 = 0.f; for (int k = 0; k < 1024; ++k) d0 += bf1(((const bf16_t*)(ws + WS_XBMID))[(size_t)row * 1024 + k]) * bf1(((const bf16_t*)(ws + WS_WQ))[(size_t)col * 1024 + k]);
        report(dg, 7, bf1(((const bf16_t*)(ws + WS_QPEER))[(size_t)row * 2048 + col]), d0, 0.05f);
    }
    if (chk == 8 && tid < 64) {
        const unsigned hh = hsh(tid * 31 + 13); const int tok = hh % T, list = (hh >> 16) % 16;
        const bf16_t* QP = (const bf16_t*)(ws + WS_QPEER) + (size_t)tok * 2048 + list * 128; const bf16_t* SK = (const bf16_t*)(ws + WS_SK) + (size_t)(l * 16 + list) * 128 * 128;
        const unsigned* TK = (const unsigned*)(ws + WS_TOPK) + ((size_t)tok * 16 + list) * 16;
        float pv = INFINITY; int pi = -1; int bad = 0;
        for (int r = 0; r < 16; ++r) {
            float bv = -INFINITY; int bi = -1;
            for (int key = 0; key < 128; ++key) { float sc = 0.f; for (int d = 0; d < 128; ++d) sc += bf1(QP[d]) * bf1(SK[key * 128 + d]);
                const bool lt = (sc < pv) || (sc == pv && key > pi); if (lt && sc > bv) { bv = sc; bi = key; } }
            const unsigned kk = TK[r]; const int gi = 127 - (int)(kk & 0x7Fu); const float gv = funmap(kk & ~0x7Fu);
            if (gi != bi) ++bad; report(dg, 9, gv, bv, 0.05f);
            pv = bv; pi = bi;
        }
        atomicMax((unsigned*)dg + 8, __float_as_uint((float)bad / 16.f));
    }
}
__device__ __forceinline__ void diag_peer(const Params& p) {
    const int tid = otid(); unsigned char* ws = p.ws; float* dg = (float*)(ws + WS_DIAG); const int l = 0;
    if (blockIdx.x != 10 || tid >= 64) return;
    const unsigned hh = hsh(tid * 37 + 17); const int tok = hh % T, d = (hh >> 16) % 1024;
    const float* XM = (const float*)(ws + WS_XMID) + (size_t)tok * 1024; const float* g2 = p.in[19] + l * 1024;
    float ss = 0.f; for (int k = 0; k < 1024; ++k) ss += XM[k] * XM[k];
    const float rstd = rsqrtf(ss / 1024.f + 1e-6f);
    const unsigned* TK = (const unsigned*)(ws + WS_TOPK) + (size_t)tok * 256;
    float outv = 0.f;
    for (int h = 0; h < 8; ++h) {
        float mx = -INFINITY, sum = 0.f, accv = 0.f;
        for (int pass = 0; pass < 2; ++pass) {
            float pv = INFINITY; int pi = -1;
            for (int r = 0; r < 16; ++r) {
                float bv = -INFINITY; int bi = -1;
                for (int c = 0; c < 256; ++c) { const float sc = funmap(TK[(2 * h) * 16 + (c >> 4)] & ~0x7Fu) + funmap(TK[(2 * h + 1) * 16 + (c & 15)] & ~0x7Fu);
                    const bool lt = (sc < pv) || (sc == pv && c > pi); if (lt && sc > bv) { bv = sc; bi = c; } }
                pv = bv; pi = bi;
                const float fs = bv * rstd;
                if (pass == 0) mx = fmaxf(mx, fs);
                else { const int eid = (127 - (int)(TK[(2 * h) * 16 + (bi >> 4)] & 0x7Fu)) * 128 + (127 - (int)(TK[(2 * h + 1) * 16 + (bi & 15)] & 0x7Fu));
                    const float e = expf(fs - mx); sum += e;
                    float dot = 0.f; for (int k = 0; k < 1024; ++k) dot += XM[k] * rstd * g2[k] * p.in[22][((size_t)l * 16384 + eid) * 1024 + k];
                    accv += e * gelu_tanh(dot) * p.in[23][((size_t)l * 16384 + eid) * 1024 + d]; }
            }
        }
        outv += accv / sum;
    }
    report(dg, 10, (p.out[(size_t)tok * 1024 + d] - XM[d]) * 0.2f, outv * 0.2f, 0.03f);
}
__device__ __forceinline__ void diag_inproj(const Params& p) {
    const int tid = otid(); unsigned char* ws = p.ws; float* dg = (float*)(ws + WS_DIAG); const int l = 0;
    const bf16_t* XB = (const bf16_t*)(ws + WS_XB);
    if (blockIdx.x == 1 && tid < 256) {
        const unsigned hh = hsh(tid * 41 + 19); const int row = hh % T, col = (hh >> 16) % 3072;
        float d0 = 0.f; for (int k = 0; k < 1024; ++k) d0 += bf1(XB[(size_t)row * 1024 + k]) * bf1(((const bf16_t*)(ws + WS_WTA))[(size_t)col * 1024 + k]);
        if (col < 1024) report(dg, 2, bf1(((const bf16_t*)(ws + WS_QK))[(size_t)row * 1024 + col]), d0, 0.02f);
        else report(dg, col < 2048 ? 1 : 11, bf1(((const bf16_t*)(ws + WS_GATE))[(size_t)row * 2048 + col - 1024]),
#ifdef DIAG_RAWGATE
 (d0 + p.in[3][l * 2048 + col - 1024])
#else
 1.f / (1.f + expf(-(d0 + p.in[3][l * 2048 + col - 1024])))
#endif
 , 0.02f);
    }
    if (blockIdx.x == 2 && tid < 256) {
        const unsigned hh = hsh(tid * 43 + 23); const int tok = hh % T, ch = (hh >> 16) % 2048;
        float d0 = 0.f; for (int k = 0; k < 1024; ++k) d0 += bf1(XB[(size_t)tok * 1024 + k]) * bf1(((const bf16_t*)(ws + WS_WTB))[(size_t)ch * 1024 + k]);
        report(dg, 2, bf1(((const bf16_t*)(ws + WS_VHT))[(size_t)ch * T + tok]), d0, 0.02f);
    }
    if (blockIdx.x == 11 && tid < 64) {
        const int tok = hsh(tid * 3 + 1) % T; float ss = 0.f; for (int k = 0; k < 1024; ++k) ss += p.in[0][(size_t)tok * 1024 + k] * p.in[0][(size_t)tok * 1024 + k];
        const int k = hsh(tid) % 1024; report(dg, 11, bf1(XB[(size_t)tok * 1024 + k]), p.in[0][(size_t)tok * 1024 + k] * rsqrtf(ss / 1024.f + 1e-6f), 1e-2f);
    }
}
__device__ __forceinline__ void diag_emit(const Params& p) {
    const float* dg = (const float*)(p.ws + WS_DIAG);
    int lowm = 0, highm = 0;
    for (int k = 0; k < 6; ++k) if (!(dg[k] <= DIAG_TOL)) lowm |= 1 << k;
    if (!(dg[6] <= DIAG_TOL)) highm |= 1; if (!(dg[7] <= DIAG_TOL)) highm |= 2; if (!(dg[8] <= 0.2f) || !(dg[9] <= DIAG_TOL)) highm |= 4;
    if (!(dg[10] <= DIAG_TOL)) highm |= 8; if (!(dg[11] <= DIAG_TOL)) highm |= 16;
    float v0 = (1.0f + 0.1f * (float)lowm) * 1000.f;
    for (int i = 0; i < highm; ++i) v0 *= 10.f;
    if (lowm == 0 && (highm & ~8) == 0) v0 = 1e4f * dg[10];
    const size_t gt = (size_t)blockIdx.x * NTHR + otid();
    for (size_t i = gt; i < (size_t)T * 1024; i += (size_t)gridDim.x * NTHR) p.out[i] = (i == 0) ? v0 : 0.f;
}
#endif

__device__ const unsigned char CAND_TAB[64] = {
    0x00, 0x01, 0x02, 0x03, 0x04, 0x05, 0x06, 0x07, 0x08, 0x09, 0x0A, 0x0B, 0x0C, 0x0D, 0x0E, 0x0F,
    0x10, 0x11, 0x12, 0x13, 0x14, 0x15, 0x16, 0x17,
    0x20, 0x21, 0x22, 0x23, 0x24,
    0x30, 0x31, 0x32, 0x33,
    0x40, 0x41, 0x42,
    0x50, 0x51, 0x60, 0x61, 0x70, 0x71,
    0x80, 0x90, 0xA0, 0xB0, 0xC0, 0xD0, 0xE0, 0xF0,
    0, 0, 0, 0, 0, 0, 0, 0, 0, 0, 0, 0, 0, 0};

#define XB_TMO      128
#define XB_XCNT(j)  (256  + 64 * (j))
#define XB_XSUB(j)  (1280 + 64 * (j))
#define XB_XGEN(j)  (2304 + 64 * (j))
#define XB_TOP      3328
#define XB_TOPGEN   3392
#define XCD_BAR_WORDS 3456
#define XB_SPIN_CAP (1u << 18)
__device__ __forceinline__ unsigned xb_ld(unsigned* p)              { return __hip_atomic_load(p, __ATOMIC_RELAXED, __HIP_MEMORY_SCOPE_AGENT); }
__device__ __forceinline__ unsigned xb_add(unsigned* p, unsigned v) { return __hip_atomic_fetch_add(p, v, __ATOMIC_RELAXED, __HIP_MEMORY_SCOPE_AGENT); }
__device__ __forceinline__ unsigned xb_xcc_id() { return (unsigned)__builtin_amdgcn_s_getreg((3 << 11) | 20) & 0xFu; }
#define XB_SPIN(cond, bar) do { unsigned _sp = 0; while (cond) { __builtin_amdgcn_s_sleep(1); \
    if ((++_sp & 255u) == 0u) { if (xb_ld(&(bar)[XB_TMO])) break; if (_sp > XB_SPIN_CAP) { atomicAdd(&(bar)[XB_TMO], 1u); break; } } } } while (0)
struct XcdBarrier { unsigned* bar; unsigned x; volatile LAS unsigned* st; };
__device__ __forceinline__ XcdBarrier xcd_barrier_post(unsigned* bar, volatile LAS unsigned* st) {
    XcdBarrier b; b.bar = bar; b.x = xb_xcc_id(); b.st = st;
    if (threadIdx.x == 0) (void)xb_add(&bar[XB_XCNT(b.x)], 1u);
    return b;
}
__device__ __forceinline__ void xcd_barrier_complete(unsigned* bar, unsigned x, unsigned& nloc, unsigned& nx) {
    const unsigned G = gridDim.x * gridDim.y * gridDim.z;
    unsigned sum, cnt, mine, sp = 0u;
    for (;;) {
        sum = 0u; cnt = 0u; mine = 0u;
#pragma unroll
        for (unsigned j = 0; j < 16; ++j) { const unsigned c = xb_ld(&bar[XB_XCNT(j)]); sum += c; cnt += (c > 0u) ? 1u : 0u; mine = (j == x) ? c : mine; }
        if (sum == G) break;
        __builtin_amdgcn_s_sleep(1);
        if ((++sp & 255u) == 0u) { if (xb_ld(&bar[XB_TMO])) break; if (sp > XB_SPIN_CAP) { atomicAdd(&bar[XB_TMO], 1u); break; } }
    }
    nloc = mine > 0u ? mine : 1u; nx = cnt > 0u ? cnt : 1u;
}
__device__ __forceinline__ void xcd_barrier(const XcdBarrier& b) {
    asm volatile("s_waitcnt vmcnt(0)" ::: "memory");
    __syncthreads();
    if (threadIdx.x == 0) {
        unsigned* bar = b.bar;
        __builtin_amdgcn_s_waitcnt(0);
        unsigned nloc = b.st[0], nx = b.st[1];
        if (nloc == 0u) { xcd_barrier_complete(bar, b.x, nloc, nx); b.st[0] = nloc; b.st[1] = nx; }
        const unsigned old = xb_add(&bar[XB_XSUB(b.x)], 1u);
        const unsigned gen = old / nloc;
        if (old + 1u == (gen + 1u) * nloc) {
            __builtin_amdgcn_fence(__ATOMIC_RELEASE, "agent");
            asm volatile("s_waitcnt vmcnt(0)" ::: "memory");
            const unsigned og = xb_add(&bar[XB_TOP], 1u);
            const unsigned tg = og / nx;
            if (og + 1u == (tg + 1u) * nx) xb_add(&bar[XB_TOPGEN], 1u);
            else XB_SPIN(xb_ld(&bar[XB_TOPGEN]) == tg, bar);
            __builtin_amdgcn_fence(__ATOMIC_ACQUIRE, "agent");
            xb_add(&bar[XB_XGEN(b.x)], 1u);
            asm volatile("s_waitcnt vmcnt(0)" ::: "memory");
        } else {
            XB_SPIN(xb_ld(&bar[XB_XGEN(b.x)]) == gen, bar);
            __builtin_amdgcn_fence(__ATOMIC_ACQUIRE, "agent");
            asm volatile("s_waitcnt vmcnt(0)" ::: "memory");
        }
    }
    __syncthreads();
}

__global__ void __launch_bounds__(NTHR) mega(Params pk) {
    extern __shared__ __attribute__((aligned(16))) unsigned char dynlds[];
    LAS unsigned char* lds = (LAS unsigned char*)dynlds;
    const int G = gridDim.x;
    const int lo = pk.ph_lo, hi = pk.ph_hi;
    cg::grid_group grid = cg::this_grid();
    { volatile LAS unsigned* xbst = (volatile LAS unsigned*)(lds + LDS_BYTES - 16);
    if (threadIdx.x < 4) xbst[threadIdx.x] = 0u;
    __syncthreads();
    (void)xcd_barrier_post((unsigned*)(load_params().ws + WS_BAR), xbst); }
#define IN(k) (lo <= (k) && (k) < hi)
#define SYNC(k) do { if (IN(k) && IN((k) + 1)) { if ((k) == 0) grid.sync(); else { XcdBarrier xb_; xb_.bar = (unsigned*)(load_params().ws + WS_BAR); xb_.x = xb_xcc_id(); xb_.st = (volatile LAS unsigned*)(lds + LDS_BYTES - 16); xcd_barrier(xb_); } } } while (0)
#define WAVE() __builtin_amdgcn_readfirstlane(otid() >> 6)

#ifndef NO_P0
    if (IN(0)) for (int rep = 0; rep < REPS(0); ++rep) { const Params p = load_params(); p0_prologue(p, lds);
#ifdef DIAG
        if (blockIdx.x == 0 && otid() < 16) ((float*)(p.ws + WS_DIAG))[otid()] = 0.f;
#endif
    }
#endif
    SYNC(0);
#pragma unroll 1
    for (int l = 0; l < DEPTH; ++l) {
        const int pb = 1 + 7 * l;
#ifndef NO_A
        if (IN(pb)) for (int rep = 0; rep < REPS(1); ++rep) {
#ifndef NO_A1
            { const Params p = load_params(); unsigned char* ws = p.ws;
              pg8::Gemm g{(const bf16_t*)(ws + WS_XB), (const bf16_t*)(ws + WS_WTA) + (size_t)l * 3072 * 1024, T, 3072, 1024};
              pg8::StaticOrder S; S.init(T, 3072, G, (int)blockIdx.x);
              pg8::EpiQKG E{(bf16_t*)(ws + WS_QK), (bf16_t*)(ws + WS_GATE), p.in[3] + l * 2048};
              pg8::gemm_phase(lds, g, S, E); }
#endif
#ifndef NO_A2
            { const Params p = load_params(); unsigned char* ws = p.ws;
              pg8::Gemm g{(const bf16_t*)(ws + WS_WTB) + (size_t)l * 2048 * 1024, (const bf16_t*)(ws + WS_XB), 2048, T, 1024};
              pg8::StaticOrder S; S.init(2048, T, G, (int)blockIdx.x);
              pg8::EpiBf16 E{(bf16_t*)(ws + WS_VHT), T};
              pg8::gemm_phase(lds, g, S, E); }
#endif
            __syncthreads();
#ifndef NO_FILT
            { const Params p = load_params();
              for (int it = blockIdx.x; it < 256; it += G) filter_item(p, lds, l, it); }
#endif
        }
#endif
        SYNC(pb);
#ifndef NO_B
        if (IN(pb + 1)) for (int rep = 0; rep < REPS(2); ++rep) {
#ifndef NO_NA
            for (int rep2 = 0; rep2 < REPS(8); ++rep2) { const Params p = load_params(); const int wave = WAVE();
              int bxm = blockIdx.x; if (G == 256) { const int x = bxm & 7; bxm = (x >> 2) * 128 + (x & 3) * 32 + (bxm >> 3); }
              for (int task = bxm * 8 + wave; task < 2048; task += G * 8) na_task(p, (LAS float*)(lds + wave * 2048), l, task); }
#endif
            __syncthreads();
#ifndef NO_HY
            for (int rep2 = 0; rep2 < REPS(9); ++rep2) { const Params p = load_params();
              for (int c = blockIdx.x; c < 512; c += G) hyena_item(p, lds, l, c); }
#endif
        }
#endif
        SYNC(pb + 1);
#ifndef NO_C
        if (IN(pb + 2)) for (int rep = 0; rep < REPS(3); ++rep) {
#ifndef NO_C1A
            { const Params p = load_params(); unsigned char* ws = p.ws;
              pg8::Gemm g{(const bf16_t*)(ws + WS_AOUT), (const bf16_t*)(ws + WS_WNA) + (size_t)l * 1024 * 512, T, 1024, 512};
              pg8::StaticOrder S; S.init(T, 1024, G, (int)blockIdx.x);
              pg8::EpiUpA E{(bf16_t*)(ws + WS_QPEER), (const bf16_t*)(ws + WS_GATE)};
              pg8::gemm_phase(lds, g, S, E); }
#endif
#ifndef NO_C1B
            { const Params p = load_params(); pg8::StaticOrder S; S.init(T, 1024, G, (int)blockIdx.x); pg8::Unit u;
              for (int i = 0; S.next(i, u); ++i) bout_panel_transpose(p, lds, u.pm);
              asm volatile("s_waitcnt vmcnt(0)" ::: "memory"); __syncthreads(); }
            { const Params p = load_params(); unsigned char* ws = p.ws;
              pg8::Gemm g{(const bf16_t*)(ws + WS_BOUT), (const bf16_t*)(ws + WS_WHY) + (size_t)l * 1024 * 512, T, 1024, 512};
              pg8::StaticOrder S; S.init(T, 1024, G, (int)blockIdx.x);
              pg8::EpiUpB E{(const bf16_t*)(ws + WS_QPEER), (const bf16_t*)(ws + WS_GATE), (bf16_t*)(ws + WS_MERGED)};
              pg8::gemm_phase(lds, g, S, E); }
#endif
        }
        SYNC(pb + 2);
        if (IN(pb + 3)) for (int rep = 0; rep < REPS(4); ++rep) {
#ifndef NO_C2
            const Params p = load_params(); unsigned char* ws = p.ws;
            pg8::Gemm g{(const bf16_t*)(ws + WS_MERGED), (const bf16_t*)(ws + WS_WOUT) + (size_t)l * 1024 * 1024, T, 1024, 1024};
            pg8::StaticOrder S; S.init(T, 1024, G, (int)blockIdx.x);
            pg8::EpiOut E{l == 0 ? p.in[0] : (const float*)p.out, (float*)(ws + WS_XMID), (bf16_t*)(ws + WS_XBMID)};
            pg8::gemm_phase(lds, g, S, E);
#endif
        }
        SYNC(pb + 3);
        if (IN(pb + 4)) for (int rep = 0; rep < REPS(5); ++rep) {
#ifndef NO_D1
            const Params p = load_params(); unsigned char* ws = p.ws;
            pg8::Gemm g{(const bf16_t*)(ws + WS_XBMID), (const bf16_t*)(ws + WS_WQ) + (size_t)l * 2048 * 1024, T, 2048, 1024};
            pg8::StaticOrder S; S.init(T, 2048, G, (int)blockIdx.x);
            pg8::EpiBf16 E{(bf16_t*)(ws + WS_QPEER), 2048};
            pg8::gemm_phase(lds, g, S, E);
#endif
        }
#endif
        SYNC(pb + 4);
#if !defined(NO_D2) && !defined(NO_E)
        if (IN(pb + 5)) for (int rep = 0; rep < REPS(7); ++rep) {
            const Params p = load_params(); const int wave = WAVE();
            if (G == 256) {
                const int x = blockIdx.x & 7, idx = blockIdx.x >> 3, tbA = x * 64 + idx, tbB = tbA + 32;
                for (int li = wave; li < 16; li += 8) { topk_task(p, (LAS float*)(lds + wave * 17408), l, tbA * 16 + li); topk_task(p, (LAS float*)(lds + wave * 17408), l, tbB * 16 + li); }
                asm volatile("s_waitcnt vmcnt(0)" ::: "memory");
                __syncthreads();
                for (int i = 0; i < 4; ++i) peer_token(p, lds + wave * 2048, l, tbA * 32 + wave * 4 + i, CAND_TAB);
                for (int i = 0; i < 4; ++i) peer_token(p, lds + wave * 2048, l, tbB * 32 + wave * 4 + i, CAND_TAB);
            } else
            for (int tb = blockIdx.x; tb < T / 32; tb += G) {
                for (int li = wave; li < 16; li += 8) topk_task(p, (LAS float*)(lds + wave * 17408), l, tb * 16 + li);
                asm volatile("s_waitcnt vmcnt(0)" ::: "memory");
                __syncthreads();
                for (int i = 0; i < 4; ++i) peer_token(p, lds + wave * 2048, l, tb * 32 + wave * 4 + i, CAND_TAB);
                __syncthreads();
            }
        }
#endif
        SYNC(pb + 5);
    }
#ifdef DIAG
    if (IN(NPHASE_ - 3)) { const Params p = load_params(); diag_inproj(p); }
    if (IN(NPHASE_ - 2)) { const Params p = load_params(); diag_checks(p); diag_peer(p); }
    if (IN(NPHASE_ - 1)) { const Params p = load_params(); diag_emit(p); }
#endif
#undef IN
#undef SYNC
}

constexpr int NPHASE = 1 + 7 * DEPTH;

extern "C" void kernel_launch(void* const* d_in, const int* in_sizes, int n_in, void* d_out, int out_size, void* d_ws, size_t ws_size, hipStream_t stream) {
    static int grid_blocks = 0;
    if (!grid_blocks) {
        int dev = 0, cus = 0, per_cu = 0;
        hipGetDevice(&dev);
        hipDeviceGetAttribute(&cus, hipDeviceAttributeMultiprocessorCount, dev);
        if (hipFuncSetAttribute((const void*)mega, hipFuncAttributeMaxDynamicSharedMemorySize, LDS_BYTES) != hipSuccess) fprintf(stderr, "hipFuncSetAttribute failed\n");
        if (hipOccupancyMaxActiveBlocksPerMultiprocessor(&per_cu, (const void*)mega, NTHR, LDS_BYTES) != hipSuccess || per_cu < 1) { fprintf(stderr, "occupancy query: %d\n", per_cu); per_cu = 1; }
        (void)hipGetLastError();
        grid_blocks = cus * per_cu;
        if (ws_size < WS_END) fprintf(stderr, "workspace too small: %zu < %zu\n", ws_size, (size_t)WS_END);
    }
    (void)hipMemsetAsync((unsigned char*)d_ws + WS_BAR, 0, 16384, stream);
    Params p{};
    for (int i = 0; i < 24; ++i) p.in[i] = (const float*)d_in[i];
    p.out = (float*)d_out; p.ws = (unsigned char*)d_ws;
#if ONE_LAUNCH
    p.ph_lo = 0; p.ph_hi = NPHASE;
    void* args[] = {&p};
    hipError_t e = hipLaunchCooperativeKernel((const void*)mega, dim3(grid_blocks), dim3(NTHR), args, LDS_BYTES, stream);
    if (e != hipSuccess) fprintf(stderr, "cooperative launch failed: %s (grid %d)\n", hipGetErrorString(e), grid_blocks);
#elif defined(DIAG)
    {
        const int seq[] = {0, 1, 2, 3, 4, 5, 6, NPHASE_ - 3, 7, NPHASE_ - 2, NPHASE_ - 1};
        for (int i = 0; i < (int)(sizeof(seq) / sizeof(int)); ++i) { p.ph_lo = seq[i]; p.ph_hi = seq[i] + 1; hipLaunchKernelGGL(mega, dim3(grid_blocks), dim3(NTHR), LDS_BYTES, stream, p); }
    }
#else
    for (int ph = 0; ph < NPHASE; ++ph) {
        p.ph_lo = ph; p.ph_hi = ph + 1;
        hipLaunchKernelGGL(mega, dim3(grid_blocks), dim3(NTHR), LDS_BYTES, stream, p);
    }
#endif
}
```
